# Optimizing an MI355X kernel written in HIP

```python
import jax, jax.numpy as jnp
from jax import lax
import numpy as np

D_MODEL = 1024
BATCH = 16
SEQ = 2048
DEPTH = 1

CHUNK = 64
Q_BLOCK = 128
EPS = 1e-6
GLA_HEADS = 4
GLA_DK = 128
GLA_DV = 256
GLA_LOWRANK = 16
GLA_TAU = 16.0
MLA_HEADS = 16
MLA_Q_RANK = 256
MLA_KV_RANK = 128
MLA_NOPE = 64
MLA_ROPE = 32
MLA_V = 64
ROPE_THETA = 10000.0
D_FF = 4 * D_MODEL
N_BRANCH = 2
IN_SPLITS = (GLA_HEADS * GLA_DK, GLA_HEADS * GLA_DK, GLA_HEADS * GLA_DV, GLA_HEADS * GLA_DV,
             GLA_LOWRANK, MLA_Q_RANK, MLA_KV_RANK, MLA_ROPE, N_BRANCH * D_MODEL)
IN_WIDTH = sum(IN_SPLITS)

kernel_name = "hybrid_gla_mla_sqrelu_adaln_block"


def rms_norm(x, g):
    xf = x.astype(jnp.float32)
    y = xf * lax.rsqrt(jnp.mean(xf * xf, axis=-1, keepdims=True) + EPS)
    return (y * g.astype(jnp.float32)).astype(x.dtype)


def modulate(h, shift, scale):
    return h * (1.0 + scale[:, None, :]) + shift[:, None, :]


def rope(x, positions):
    r = x.shape[-1]
    freqs = ROPE_THETA ** (-jnp.arange(0, r, 2, dtype=jnp.float32) / r)
    ang = positions.astype(jnp.float32)[..., None] * freqs
    cos = jnp.cos(ang)[:, :, None, :]
    sin = jnp.sin(ang)[:, :, None, :]
    xf = x.astype(jnp.float32)
    x1, x2 = xf[..., : r // 2], xf[..., r // 2:]
    return jnp.concatenate([x1 * cos - x2 * sin, x2 * cos + x1 * sin], axis=-1).astype(x.dtype)


def gla_branch(q, k, v, g, a_lr, w_alpha, b_alpha, out_norm_g, w_o):
    b, s, _ = q.shape
    nc = s // CHUNK
    qc = q.reshape(b, nc, CHUNK, GLA_HEADS, GLA_DK) * (GLA_DK ** -0.5)
    kc = k.reshape(b, nc, CHUNK, GLA_HEADS, GLA_DK)
    vc = v.reshape(b, nc, CHUNK, GLA_HEADS, GLA_DV)
    log_a = jax.nn.log_sigmoid((a_lr @ w_alpha + b_alpha).astype(jnp.float32)) / GLA_TAU
    log_a = log_a.reshape(b, nc, CHUNK, GLA_HEADS, GLA_DK)
    cum = jnp.cumsum(log_a, axis=2)
    cum_end = cum[:, :, -1]
    k_dec = kc.astype(jnp.float32) * jnp.exp(cum_end[:, :, None] - cum)
    u = jnp.einsum('bnchk,bnchv->nbhkv', k_dec, vc.astype(jnp.float32))
    decay = jnp.transpose(jnp.exp(cum_end), (1, 0, 2, 3))

    def step(state, inp):
        d, uc = inp
        state = d[..., None] * state + uc
        return state, state

    s0 = jnp.zeros((b, GLA_HEADS, GLA_DK, GLA_DV), jnp.float32)
    _, states = lax.scan(step, s0, (decay, u))
    o = jnp.einsum('bnchk,nbhkv->bnchv', qc.astype(jnp.float32), states).astype(q.dtype)
    o = o.reshape(b, s, GLA_HEADS, GLA_DV)
    o = rms_norm(o, out_norm_g) * jax.nn.silu(g.reshape(b, s, GLA_HEADS, GLA_DV))
    return o.reshape(b, s, GLA_HEADS * GLA_DV) @ w_o


def chunk_causal_attention(q, k, v):
    b, s, h, dqk = q.shape
    dv = v.shape[-1]
    nb = s // Q_BLOCK
    scale = dqk ** -0.5
    qb = jnp.transpose(q.reshape(b, nb, Q_BLOCK, h, dqk), (1, 0, 3, 2, 4))
    key_chunk = jnp.arange(s) // CHUNK

    def one_block(args):
        qi, bi = args
        sc = jnp.einsum('bhqd,bkhd->bhqk', qi, k).astype(jnp.float32) * scale
        q_chunk = (bi * Q_BLOCK + jnp.arange(Q_BLOCK)) // CHUNK
        mask = key_chunk[None, :] <= q_chunk[:, None]
        sc = jnp.where(mask[None, None], sc, -jnp.inf)
        p = jax.nn.softmax(sc, axis=-1).astype(v.dtype)
        return jnp.einsum('bhqk,bkhd->bqhd', p, v)

    out = lax.map(one_block, (qb, jnp.arange(nb)))
    return jnp.transpose(out, (1, 0, 2, 3, 4)).reshape(b, s, h, dv)


def mla_branch(cq, ckv, kpe, positions, q_lat_g, w_uq, kv_lat_g, w_ukv, qn_g, kn_g, w_o):
    b, s, _ = cq.shape
    q = (rms_norm(cq, q_lat_g) @ w_uq).reshape(b, s, MLA_HEADS, MLA_NOPE + MLA_ROPE)
    kv = (rms_norm(ckv, kv_lat_g) @ w_ukv).reshape(b, s, MLA_HEADS, MLA_NOPE + MLA_V)
    k_nope, v = kv[..., :MLA_NOPE], kv[..., MLA_NOPE:]
    k_rope = jnp.broadcast_to(kpe[:, :, None, :], (b, s, MLA_HEADS, MLA_ROPE))
    k = jnp.concatenate([k_nope, k_rope], axis=-1)
    q = rms_norm(q, qn_g)
    k = rms_norm(k, kn_g)
    q = jnp.concatenate([q[..., :MLA_NOPE], rope(q[..., MLA_NOPE:], positions)], axis=-1)
    k = jnp.concatenate([k[..., :MLA_NOPE], rope(k[..., MLA_NOPE:], positions)], axis=-1)
    o = chunk_causal_attention(q, k, v)
    return o.reshape(b, s, MLA_HEADS * MLA_V) @ w_o


def setup_inputs(seed: int = 0) -> dict:
    key = jax.random.key(seed)
    ks = jax.random.split(key, 24)
    f32 = jnp.float32

    def nrm(k, shape, scale):
        return jax.random.normal(k, shape, f32) * scale

    def gain(k, dim):
        return 1.0 + 0.02 * jax.random.normal(k, (DEPTH, dim), f32)

    L = DEPTH
    offsets = jax.random.randint(ks[2], (BATCH, 1), 0, 4096, dtype=jnp.int32)
    positions = offsets + jnp.arange(SEQ, dtype=jnp.int32)[None, :]
    return {
        "x": nrm(ks[0], (BATCH, SEQ, D_MODEL), 1.0),
        "c": nrm(ks[1], (BATCH, D_MODEL), 1.0),
        "positions": positions,
        "w_ada": nrm(ks[3], (L, D_MODEL, 6 * D_MODEL), 0.5 * D_MODEL ** -0.5),
        "b_ada": nrm(ks[4], (L, 6 * D_MODEL), 0.02),
        "norm1_g": gain(ks[5], D_MODEL),
        "w_in": nrm(ks[6], (L, D_MODEL, IN_WIDTH), D_MODEL ** -0.5),
        "b_merge": nrm(ks[7], (L, N_BRANCH * D_MODEL), 0.02),
        "gla_w_alpha": nrm(ks[8], (L, GLA_LOWRANK, GLA_HEADS * GLA_DK), GLA_LOWRANK ** -0.5),
        "gla_b_alpha": nrm(ks[9], (L, GLA_HEADS * GLA_DK), 0.1),
        "gla_out_norm_g": gain(ks[10], GLA_DV),
        "gla_w_o": nrm(ks[11], (L, GLA_HEADS * GLA_DV, D_MODEL), (GLA_HEADS * GLA_DV) ** -0.5),
        "mla_q_lat_g": gain(ks[12], MLA_Q_RANK),
        "mla_w_uq": nrm(ks[13], (L, MLA_Q_RANK, MLA_HEADS * (MLA_NOPE + MLA_ROPE)), MLA_Q_RANK ** -0.5),
        "mla_kv_lat_g": gain(ks[14], MLA_KV_RANK),
        "mla_w_ukv": nrm(ks[15], (L, MLA_KV_RANK, MLA_HEADS * (MLA_NOPE + MLA_V)), MLA_KV_RANK ** -0.5),
        "mla_qn_g": gain(ks[16], MLA_NOPE + MLA_ROPE),
        "mla_kn_g": gain(ks[17], MLA_NOPE + MLA_ROPE),
        "mla_w_o": nrm(ks[18], (L, MLA_HEADS * MLA_V, D_MODEL), (MLA_HEADS * MLA_V) ** -0.5),
        "w_out": nrm(ks[19], (L, D_MODEL, D_MODEL), D_MODEL ** -0.5),
        "norm2_g": gain(ks[20], D_MODEL),
        "mlp_w1": nrm(ks[21], (L, D_MODEL, D_FF), D_MODEL ** -0.5),
        "mlp_w2": nrm(ks[22], (L, D_FF, D_MODEL), D_FF ** -0.5),
    }


def reference(x, c, positions, w_ada, b_ada, norm1_g, w_in, b_merge, gla_w_alpha, gla_b_alpha,
              gla_out_norm_g, gla_w_o, mla_q_lat_g, mla_w_uq, mla_kv_lat_g, mla_w_ukv,
              mla_qn_g, mla_kn_g, mla_w_o, w_out, norm2_g, mlp_w1, mlp_w2):
    split_at = np.cumsum(IN_SPLITS)[:-1].tolist()
    c_act = jax.nn.silu(c)
    for l in range(DEPTH):
        mod = c_act @ w_ada[l] + b_ada[l]
        shift1, scale1, gate1, shift2, scale2, gate2 = jnp.split(mod, 6, axis=-1)

        h = modulate(rms_norm(x, norm1_g[l]), shift1, scale1)
        proj = h @ w_in[l]
        g_q, g_k, g_v, g_g, g_a, m_cq, m_ckv, m_kpe, merge_logits = jnp.split(proj, split_at, axis=-1)
        y_a = gla_branch(g_q, g_k, g_v, g_g, g_a, gla_w_alpha[l], gla_b_alpha[l],
                         gla_out_norm_g[l], gla_w_o[l])
        y_b = mla_branch(m_cq, m_ckv, m_kpe, positions, mla_q_lat_g[l], mla_w_uq[l],
                         mla_kv_lat_g[l], mla_w_ukv[l], mla_qn_g[l], mla_kn_g[l], mla_w_o[l])
        gates = jax.nn.sigmoid(merge_logits + b_merge[l])
        gate_a, gate_b = gates[..., :D_MODEL], gates[..., D_MODEL:]
        mixed = (gate_a * y_a + gate_b * y_b) @ w_out[l]
        x = x + gate1[:, None, :] * mixed

        h2 = modulate(rms_norm(x, norm2_g[l]), shift2, scale2)
        ff = jnp.square(jax.nn.relu(h2 @ mlp_w1[l])) @ mlp_w2[l]
        x = x + gate2[:, None, :] * ff
    return x
```

```cpp
#include <hip/hip_runtime.h>
#include <hip/hip_cooperative_groups.h>
#include <cstdio>
#include <cstdint>
namespace cg = cooperative_groups;

#define LAS __attribute__((address_space(3)))
#define GAS __attribute__((address_space(1)))
typedef unsigned short bf16_t;
typedef short bf16x8 __attribute__((ext_vector_type(8)));
typedef float f32x4 __attribute__((ext_vector_type(4)));
typedef float f32x2 __attribute__((ext_vector_type(2)));
typedef float f32x16 __attribute__((ext_vector_type(16)));
typedef unsigned u32x4 __attribute__((ext_vector_type(4)));
typedef unsigned u32x2 __attribute__((ext_vector_type(2)));
typedef __bf16 bf16x2_t __attribute__((ext_vector_type(2)));

#define DI __device__ __forceinline__
DI unsigned pk2(float lo, float hi) { f32x2 v = {lo, hi}; bf16x2_t b = __builtin_convertvector(v, bf16x2_t); return __builtin_bit_cast(unsigned, b); }
DI unsigned short f2bf(float f) { return (unsigned short)(pk2(f, 0.f) & 0xffffu); }
DI float bflo(unsigned w) { return __uint_as_float(w << 16); }
DI float bfhi(unsigned w) { return __uint_as_float(w & 0xffff0000u); }
DI void unpack8(u32x4 w, float* f) { f[0] = bflo(w.x); f[1] = bfhi(w.x); f[2] = bflo(w.y); f[3] = bfhi(w.y); f[4] = bflo(w.z); f[5] = bfhi(w.z); f[6] = bflo(w.w); f[7] = bfhi(w.w); }
DI u32x4 pack8(const float* f) { u32x4 w; w.x = pk2(f[0], f[1]); w.y = pk2(f[2], f[3]); w.z = pk2(f[4], f[5]); w.w = pk2(f[6], f[7]); return w; }
DI void st_bf8(bf16_t* p, f32x4 a, f32x4 b) { u32x4 w; w.x = pk2(a[0], a[1]); w.y = pk2(a[2], a[3]); w.z = pk2(b[0], b[1]); w.w = pk2(b[2], b[3]); *(u32x4*)p = w; }
template <int CTRL> DI float dpp_f(float x) { return __int_as_float(__builtin_amdgcn_mov_dpp(__float_as_int(x), CTRL, 0xf, 0xf, true)); }
DI float xor_add32(float x) { auto rr = __builtin_amdgcn_permlane32_swap(__float_as_uint(x), __float_as_uint(x), false, false); return __uint_as_float(rr[0]) + __uint_as_float(rr[1]); }
DI float xor_max32(float x) { auto rr = __builtin_amdgcn_permlane32_swap(__float_as_uint(x), __float_as_uint(x), false, false); return fmaxf(__uint_as_float(rr[0]), __uint_as_float(rr[1])); }
DI float xor_add16(float x) { auto rr = __builtin_amdgcn_permlane16_swap(__float_as_uint(x), __float_as_uint(x), false, false); return __uint_as_float(rr[0]) + __uint_as_float(rr[1]); }
DI float row16_sum(float v) { v += dpp_f<0xB1>(v); v += dpp_f<0x4E>(v); v += dpp_f<0x141>(v); v += dpp_f<0x140>(v); return v; }
DI float wave_sum(float v) { v = row16_sum(v); v = xor_add16(v); return xor_add32(v); }
DI float xor_max16(float x) { auto rr = __builtin_amdgcn_permlane16_swap(__float_as_uint(x), __float_as_uint(x), false, false); return fmaxf(__uint_as_float(rr[0]), __uint_as_float(rr[1])); }
DI float wave_max(float v) { v = fmaxf(v, dpp_f<0xB1>(v)); v = fmaxf(v, dpp_f<0x4E>(v)); v = fmaxf(v, dpp_f<0x141>(v)); v = fmaxf(v, dpp_f<0x140>(v)); v = xor_max16(v); return xor_max32(v); }
#define LDS_BARRIER() do { asm volatile("s_waitcnt lgkmcnt(0)" ::: "memory"); __builtin_amdgcn_s_barrier(); asm volatile("" ::: "memory"); } while (0)
DI float sigmoidf_(float x) { return __builtin_amdgcn_rcpf(1.0f + __expf(-x)); }
DI float rsq_(float x) { return __builtin_amdgcn_rsqf(x); }

constexpr int MTOK = 32768, DMODEL = 1024, SEQ = 2048, NBATCH = 16, DFF = 4096;
constexpr float EPS = 1e-6f;
constexpr int INW = 5552;
constexpr int C_GQ = 0, C_GK = 512, C_GV = 1024, C_GG = 2048, C_GA = 3072, C_CQ = 3088, C_CKV = 3344, C_KPE = 3472, C_MG = 3504;

constexpr size_t MB = 1u << 20;
constexpr size_t OFF_MOD = 0, OFF_COS = 1 * MB, OFF_SIN = 3 * MB, OFF_DECAY = 5 * MB, OFF_KPER = 6 * MB, OFF_KPESS = 8 * MB, OFF_KSS = 9 * MB,
                 OFF_KPE = 11 * MB, OFF_ALR = 15 * MB, OFF_CQSS = 17 * MB, OFF_CKVSS = 17 * MB + 256 * 1024, OFF_CTL = 17 * MB + 512 * 1024;
constexpr size_t OFF_WINN = 18 * MB, OFF_WINT = 26 * MB, OFF_WUQT = 29 * MB, OFF_WUKT = 30 * MB, OFF_WUVT = 30 * MB + 256 * 1024, OFF_WGOT = 31 * MB,
                 OFF_WMOT = 33 * MB, OFF_WOUTT = 35 * MB, OFF_W1T = 37 * MB, OFF_W2T = 45 * MB;
constexpr size_t SL1 = 54 * MB, SL2 = 118 * MB, SL3 = 182 * MB, SL4 = 246 * MB, SL5 = 310 * MB, SL6 = 374 * MB;
constexpr size_t OFF_GATEA = SL1, OFF_KNOPE = SL1, OFF_HB2 = SL1;
constexpr size_t OFF_GATEB = SL2, OFF_HID = SL2;
constexpr size_t OFF_GS = SL3, OFF_MIX = SL3;
constexpr size_t OFF_VT = SL4, OFF_VMT = SL4;
constexpr size_t OFF_HB = SL5, OFF_OG = SL5, OFF_OM = SL5;
constexpr size_t OFF_QG = SL6, OFF_KT = SL6 + 32 * MB, OFF_Q = SL6;
constexpr size_t OFF_CQN = 470 * MB, OFF_CKVN = 486 * MB;
constexpr size_t WS_END = 502 * MB;

struct Params {
  const float *x, *c; const int* pos;
  const float *w_ada, *b_ada, *norm1_g, *w_in, *b_merge, *w_alpha, *b_alpha, *gla_gn, *gla_w_o, *q_lat_g, *w_uq, *kv_lat_g, *w_ukv, *qn_g, *kn_g, *mla_w_o,
      *w_out, *norm2_g, *w1, *w2;
  float* out; unsigned char* ws;
};

namespace pg8 {
constexpr int BM = 256, BK = 64, HALF = 128, HTB = HALF * BK * 2, STAGE_BYTES = 8 * HTB, NXCD = 8, WGM = 8;
__host__ __device__ __forceinline__ int lds_byte(int r, int c) { const int st = (r >> 4) * 2 + (c >> 5), rr = r & 15, cc = c & 31, ob = rr * 64 + cc * 2; return st * 1024 + (ob ^ (((ob >> 9) & 1) << 5)); }
__host__ __device__ __forceinline__ void stage_rc(int b, int& R, int& C) { const int st = b / 1024, sb = b % 1024, swz = sb ^ (((sb >> 9) & 1) << 5); R = (st >> 1) * 16 + swz / 64; C = (st & 1) * 32 + (swz % 64) / 2; }
__host__ __device__ __forceinline__ int perm32(int rho) { const int n = rho >> 4, i = rho & 15; return 8 * (i >> 2) + 4 * n + (i & 3); }
struct Unit { int pm, pn; };
struct Gemm { const bf16_t* A; const bf16_t* Bt; int M, N, K; };
struct StaticOrder {
  int nM, nN, nwg, G, c;
  __device__ void init(int M, int N, int G_, int c_) { nM = M / BM; nN = N / BM; nwg = nM * nN; G = G_; c = c_; }
  __device__ bool next(int i, Unit& u) const {
    const long L = (long)i * G + c; if (L >= nwg) return false;
    int wgid = (int)L; { const int q = nwg / NXCD, r = nwg % NXCD, xcd = wgid % NXCD, off = wgid / NXCD; wgid = (xcd < r ? xcd * (q + 1) : r * (q + 1) + (xcd - r) * q) + off; }
    const int nig = WGM * nN, gid = wgid / nig, fm = gid * WGM, gsz = (nM - fm) < WGM ? (nM - fm) : WGM;
    u.pm = fm + ((wgid % nig) % gsz); u.pn = (wgid % nig) / gsz; return true;
  }
};
template <class Epi>
__device__ __forceinline__ void gemm_phase(LAS unsigned char* lds, const Gemm g, const StaticOrder& S, const Epi& E, const int tid) {
  const int wid = __builtin_amdgcn_readfirstlane(tid >> 6), lane = tid & 63, wr = wid >> 2, wc = wid & 3, fr = lane & 15, fq = lane >> 4;
  const int K = g.K, nt = K / BK;
  unsigned voffA[2], voffB[2];
#pragma unroll
  for (int i = 0; i < 2; ++i) { int R, C; stage_rc(tid * 16 + i * 8192, R, C); const int Rb = (R & ~31) + perm32(R & 31);
    voffA[i] = (unsigned)(R * K + C) * 2u; voffB[i] = (unsigned)(Rb * K + C) * 2u; }
  const size_t kstep = (size_t)(BK * 2);
  const size_t hstep = (size_t)HALF * K * 2;
  const size_t tstep = 2 * hstep;
  const unsigned ldsw = (unsigned)wid * 1024u;
  const int aoff = lds_byte(wr * 64 + fr, fq * 8), boff = lds_byte(wc * 32 + fr, fq * 8);
#define PG8_SA(b, h) (((b) * 2 + (h)) * HTB)
#define PG8_SB(b, h) ((4 + (b) * 2 + (h)) * HTB)
#define PG8_STAGE(bufoff, gbase, voff) do { _Pragma("unroll") for (int _i = 0; _i < 2; ++_i) \
    __builtin_amdgcn_global_load_lds((const unsigned*)((const char*)(gbase) + (voff)[_i]), (LAS unsigned*)(lds + (bufoff) + ldsw + _i * 8192), 16, 0, 0); } while (0)
#define PG8_LDA(dst, b, h) do { _Pragma("unroll") for (int m = 0; m < 4; ++m) _Pragma("unroll") for (int k = 0; k < 2; ++k) dst[m][k] = *(const LAS bf16x8*)(lds + PG8_SA(b, h) + aoff + m * 2048 + k * 1024); } while (0)
#define PG8_LDB(dst, b, h) do { _Pragma("unroll") for (int n = 0; n < 2; ++n) _Pragma("unroll") for (int k = 0; k < 2; ++k) dst[n][k] = *(const LAS bf16x8*)(lds + PG8_SB(b, h) + boff + n * 2048 + k * 1024); } while (0)
#define PG8_MMA(ai, bj, At, Bt) do { __builtin_amdgcn_s_setprio(1); _Pragma("unroll") for (int m = 0; m < 4; ++m) _Pragma("unroll") for (int n = 0; n < 2; ++n) _Pragma("unroll") for (int k = 0; k < 2; ++k) \
    acc[ai][bj][m][n] = __builtin_amdgcn_mfma_f32_16x16x32_bf16(Bt[n][k], At[m][k], acc[ai][bj][m][n], 0, 0, 0); __builtin_amdgcn_s_setprio(0); } while (0)
#define PG8_WAIT_V(n) asm volatile("s_waitcnt vmcnt(" #n ")" ::: "memory")
#define PG8_WAIT_L(n) asm volatile("s_waitcnt lgkmcnt(" #n ")" ::: "memory")
#define PG8_BAR __builtin_amdgcn_s_barrier()
#define PG8_SCHED __builtin_amdgcn_sched_barrier(0)
  Unit cur, nxt; int ui = 0;
  if (!S.next(0, cur)) return;
  f32x4 acc[2][2][4][2];
#pragma unroll
  for (int a = 0; a < 2; ++a)
#pragma unroll
    for (int b = 0; b < 2; ++b)
#pragma unroll
      for (int m = 0; m < 4; ++m)
#pragma unroll
        for (int n = 0; n < 2; ++n) acc[a][b][m][n] = (f32x4){0.f, 0.f, 0.f, 0.f};
  bf16x8 At[4][2], B0[2][2], B1[2][2];
  const char* cA = (const char*)g.A + (size_t)cur.pm * tstep; const char* cB = (const char*)g.Bt + (size_t)cur.pn * tstep;
  PG8_STAGE(PG8_SB(0, 0), cB, voffB); PG8_STAGE(PG8_SB(0, 1), cB + hstep, voffB); PG8_STAGE(PG8_SA(0, 0), cA, voffA); PG8_STAGE(PG8_SA(0, 1), cA + hstep, voffA);
  if (wr == 1) PG8_BAR;
  PG8_WAIT_V(2); PG8_BAR;
  PG8_STAGE(PG8_SB(1, 0), cB + kstep, voffB); PG8_STAGE(PG8_SA(1, 0), cA + kstep, voffA); PG8_STAGE(PG8_SB(1, 1), cB + hstep + kstep, voffB);
  PG8_WAIT_V(6); PG8_BAR;
  for (;;) {
    const bool has_next = S.next(ui + 1, nxt);
    const char* nA = has_next ? (const char*)g.A + (size_t)nxt.pm * tstep : cA; const char* nB = has_next ? (const char*)g.Bt + (size_t)nxt.pn * tstep : cB;
    for (int t = 0; t < nt; t += 2) {
      const bool last = (t == nt - 2);
      const char* a1 = cA + (size_t)(t + 1) * kstep;
      const char* a2 = last ? nA : cA + (size_t)(t + 2) * kstep; const char* b2 = last ? nB : cB + (size_t)(t + 2) * kstep;
      const char* a3 = a2 + kstep; const char* b3 = b2 + kstep;
      PG8_LDB(B0, 0, 0); PG8_LDB(B1, 0, 1); PG8_SCHED; PG8_LDA(At, 0, 0); PG8_STAGE(PG8_SA(1, 1), a1 + hstep, voffA);
      PG8_WAIT_V(8); PG8_WAIT_L(0); PG8_BAR; PG8_MMA(0, 0, At, B0); PG8_MMA(0, 1, At, B1); PG8_BAR; PG8_SCHED;
      PG8_LDA(At, 0, 1); PG8_STAGE(PG8_SB(0, 0), b2, voffB); PG8_STAGE(PG8_SB(0, 1), b2 + hstep, voffB); PG8_STAGE(PG8_SA(0, 0), a2, voffA);
      PG8_WAIT_V(8); PG8_WAIT_L(0); PG8_BAR; PG8_MMA(1, 0, At, B0); PG8_MMA(1, 1, At, B1); PG8_BAR; PG8_SCHED;
      PG8_LDB(B0, 1, 0); PG8_LDB(B1, 1, 1); PG8_SCHED; PG8_LDA(At, 1, 0); PG8_STAGE(PG8_SA(0, 1), a2 + hstep, voffA);
      PG8_WAIT_V(8); PG8_WAIT_L(0); PG8_BAR; PG8_MMA(0, 0, At, B0); PG8_MMA(0, 1, At, B1); PG8_BAR; PG8_SCHED;
      PG8_LDA(At, 1, 1); PG8_STAGE(PG8_SB(1, 0), b3, voffB); PG8_STAGE(PG8_SB(1, 1), b3 + hstep, voffB); PG8_STAGE(PG8_SA(1, 0), a3, voffA);
      PG8_WAIT_V(8); PG8_WAIT_L(0); PG8_BAR; PG8_MMA(1, 0, At, B0); PG8_MMA(1, 1, At, B1); PG8_BAR; PG8_SCHED;
    }
    if (wr == 0) PG8_BAR;
#pragma unroll
    for (int ai = 0; ai < 2; ++ai)
#pragma unroll
      for (int m = 0; m < 4; ++m) {
        const int row = cur.pm * BM + ai * HALF + wr * 64 + m * 16 + fr;
#pragma unroll
        for (int bj = 0; bj < 2; ++bj) E(row, cur.pn * BM + bj * HALF + wc * 32 + 8 * fq, acc[ai][bj][m][0], acc[ai][bj][m][1]);
      }
    if (!has_next) break;
#pragma unroll
    for (int a = 0; a < 2; ++a)
#pragma unroll
      for (int b = 0; b < 2; ++b)
#pragma unroll
        for (int m = 0; m < 4; ++m)
#pragma unroll
          for (int n = 0; n < 2; ++n) acc[a][b][m][n] = (f32x4){0.f, 0.f, 0.f, 0.f};
    cur = nxt; cA = nA; cB = nB; ++ui;
    if (wr == 1) PG8_BAR;
  }
  PG8_WAIT_V(0);
  PG8_BAR;
#undef PG8_SA
#undef PG8_SB
#undef PG8_STAGE
#undef PG8_LDA
#undef PG8_LDB
#undef PG8_MMA
#undef PG8_WAIT_V
#undef PG8_WAIT_L
#undef PG8_BAR
#undef PG8_SCHED
}
}

enum { EPI_PROJN = 0, EPI_PROJT, EPI_YA, EPI_QUP, EPI_KUP, EPI_VUPT, EPI_YB, EPI_WOUT, EPI_W1, EPI_W2 };
struct EpiSwitch {
  int id; unsigned char* ws; const float* x; float* out; const float* b_merge; const float* q_lat_g; const float* kv_lat_g; int dry;
  DI void operator()(int row, int col, f32x4 v0, f32x4 v1) const {
    switch (id) {
      case EPI_PROJN: {
        if (col < 512) { const float s = 0.08838834764831845f; st_bf8((bf16_t*)(ws + OFF_QG) + (size_t)row * 512 + col, v0 * s, v1 * s); }
        else if (col < 1536) {
#pragma unroll
          for (int i = 0; i < 4; ++i) { v0[i] = v0[i] * sigmoidf_(v0[i]); v1[i] = v1[i] * sigmoidf_(v1[i]); }
          st_bf8((bf16_t*)(ws + OFF_GS) + (size_t)row * 1024 + (col - 512), v0, v1);
        } else if (col < 3584) {
          const int c2 = col - 1536; const f32x4 b0 = *(const f32x4*)(b_merge + c2), b1 = *(const f32x4*)(b_merge + c2 + 4);
#pragma unroll
          for (int i = 0; i < 4; ++i) { v0[i] = sigmoidf_(v0[i] + b0[i]); v1[i] = sigmoidf_(v1[i] + b1[i]); }
          bf16_t* dst = (c2 < 1024) ? (bf16_t*)(ws + OFF_GATEA) + (size_t)row * 1024 + c2 : (bf16_t*)(ws + OFF_GATEB) + (size_t)row * 1024 + (c2 - 1024);
          st_bf8(dst, v0, v1);
        } else if (col < 3968) {
          const bool isq = col < 3840; const int c2 = isq ? col - 3584 : col - 3840; const float* gp = (isq ? q_lat_g : kv_lat_g) + c2;
          const f32x4 g0 = *(const f32x4*)gp, g1 = *(const f32x4*)(gp + 4);
          float ss = (v0[0] * v0[0] + v0[1] * v0[1]) + (v0[2] * v0[2] + v0[3] * v0[3]) + (v1[0] * v1[0] + v1[1] * v1[1]) + (v1[2] * v1[2] + v1[3] * v1[3]);
          ss = xor_add16(ss); ss = xor_add32(ss);
          bf16_t* dst = isq ? (bf16_t*)(ws + OFF_CQN) + (size_t)row * 256 + c2 : (bf16_t*)(ws + OFF_CKVN) + (size_t)row * 128 + c2;
          st_bf8(dst, v0 * g0, v1 * g1);
          if ((threadIdx.x & 48) == 0) atomicAdd((float*)(ws + (isq ? OFF_CQSS : OFF_CKVSS)) + row, ss);
        }
        else if (col < 4000) { float* d = (float*)(ws + OFF_KPE) + (size_t)row * 32 + (col - 3968); *(f32x4*)d = v0; *(f32x4*)(d + 4) = v1; }
        else if (col < 4016) { float* d = (float*)(ws + OFF_ALR) + (size_t)row * 16 + (col - 4000); *(f32x4*)d = v0; *(f32x4*)(d + 4) = v1; }
      } break;
      case EPI_PROJT: {
        bf16_t* dst = (row < 512) ? (bf16_t*)(ws + OFF_KT) + ((size_t)(col >> 6) * 512 + row) * 64 + (col & 63) : (bf16_t*)(ws + OFF_VT) + ((size_t)(col >> 6) * 1024 + (row - 512)) * 64 + (col & 63);
        st_bf8(dst, v0, v1);
      } break;
      case EPI_YA: {
        const u32x4 gw = *(const u32x4*)((const bf16_t*)(ws + OFF_GATEA) + (size_t)row * 1024 + col); float g[8]; unpack8(gw, g);
#pragma unroll
        for (int i = 0; i < 4; ++i) { v0[i] *= g[i]; v1[i] *= g[4 + i]; }
        st_bf8((bf16_t*)(ws + OFF_MIX) + (size_t)row * 1024 + col, v0, v1);
      } break;
      case EPI_QUP: { const float al = rsq_(((const float*)(ws + OFF_CQSS))[row] * (1.0f / 256.0f) + EPS);
        st_bf8((bf16_t*)(ws + OFF_Q) + (size_t)row * 1536 + col, v0 * al, v1 * al); } break;
      case EPI_KUP: { const float al = rsq_(((const float*)(ws + OFF_CKVSS))[row] * (1.0f / 128.0f) + EPS);
        v0 = v0 * al; v1 = v1 * al;
        float ss = (v0[0] * v0[0] + v0[1] * v0[1]) + (v0[2] * v0[2] + v0[3] * v0[3]) + (v1[0] * v1[0] + v1[1] * v1[1]) + (v1[2] * v1[2] + v1[3] * v1[3]);
        ss = xor_add16(ss); ss = xor_add32(ss);
        st_bf8((bf16_t*)(ws + OFF_KNOPE) + ((size_t)((row >> 11) * 16 + (col >> 6)) * 2048 + (row & 2047)) * 64 + (col & 63), v0, v1);
        if ((threadIdx.x & 48) == 0) atomicAdd((float*)(ws + OFF_KSS) + (size_t)row * 16 + (col >> 6), ss); } break;
      case EPI_VUPT: { const float* cs = (const float*)(ws + OFF_CKVSS) + col; const f32x4 c0 = *(const f32x4*)cs, c1 = *(const f32x4*)(cs + 4);
#pragma unroll
        for (int i = 0; i < 4; ++i) { v0[i] *= rsq_(c0[i] * (1.0f / 128.0f) + EPS); v1[i] *= rsq_(c1[i] * (1.0f / 128.0f) + EPS); }
        st_bf8((bf16_t*)(ws + OFF_VMT) + ((size_t)(col >> 6) * 1024 + row) * 64 + (col & 63), v0, v1); } break;
      case EPI_YB: {
        const u32x4 gw = *(const u32x4*)((const bf16_t*)(ws + OFF_GATEB) + (size_t)row * 1024 + col); float g[8]; unpack8(gw, g);
        bf16_t* mp = (bf16_t*)(ws + OFF_MIX) + (size_t)row * 1024 + col; const u32x4 tw = *(const u32x4*)mp; float t[8]; unpack8(tw, t);
#pragma unroll
        for (int i = 0; i < 4; ++i) { v0[i] = t[i] + v0[i] * g[i]; v1[i] = t[4 + i] + v1[i] * g[4 + i]; }
        st_bf8(dry ? (bf16_t*)(ws + SL4) + (size_t)row * 1024 + col : mp, v0, v1);
      } break;
      case EPI_WOUT: {
        const float* mod = (const float*)(ws + OFF_MOD) + (size_t)(row >> 11) * 6144 + 2048 + col;
        const f32x4 g0 = *(const f32x4*)mod, g1 = *(const f32x4*)(mod + 4);
        const float* xp = x + (size_t)row * 1024 + col; const f32x4 x0 = __builtin_nontemporal_load((const f32x4*)xp), x1 = __builtin_nontemporal_load((const f32x4*)(xp + 4));
        float* op = out + (size_t)row * 1024 + col; *(f32x4*)op = x0 + g0 * v0; *(f32x4*)(op + 4) = x1 + g1 * v1;
      } break;
      case EPI_W1: {
#pragma unroll
        for (int i = 0; i < 4; ++i) { const float a = fmaxf(v0[i], 0.f), b = fmaxf(v1[i], 0.f); v0[i] = a * a; v1[i] = b * b; }
        { u32x4 w; w.x = pk2(v0[0], v0[1]); w.y = pk2(v0[2], v0[3]); w.z = pk2(v1[0], v1[1]); w.w = pk2(v1[2], v1[3]); __builtin_nontemporal_store(w, (u32x4*)((bf16_t*)(ws + OFF_HID) + (size_t)row * 4096 + col)); }
      } break;
      case EPI_W2: {
        const float* mod = (const float*)(ws + OFF_MOD) + (size_t)(row >> 11) * 6144 + 5120 + col;
        const f32x4 g0 = *(const f32x4*)mod, g1 = *(const f32x4*)(mod + 4);
        float* op = out + (size_t)row * 1024 + col; const f32x4 x0 = *(const f32x4*)op, x1 = *(const f32x4*)(op + 4);
        if (dry) op = (float*)(ws + SL6) + (size_t)row * 1024 + col;
        __builtin_nontemporal_store(x0 + g0 * v0, (f32x4*)op); __builtin_nontemporal_store(x1 + g1 * v1, (f32x4*)(op + 4));
      } break;
    }
  }
};

DI void tr_item(const float* __restrict__ src, int ld, int col0, int gs, int nvalid, int nrows, int K, bf16_t* dst, LAS float* scr, int item, int lane, bool sw23 = false) {
  const int nblk = nrows / 32, kb = item / nblk, nb = item % nblk, k0 = 64 * kb, n0 = 32 * nb;
  const int n = n0 + (lane & 31); const int ns = sw23 ? ((n & ~12) | ((n & 4) << 1) | ((n & 8) >> 1)) : n; const int scol = col0 + (ns >> 6) * gs + (ns & 63); const bool ok = n < nvalid;
#pragma unroll
  for (int i = 0; i < 32; ++i) { const int kk = 2 * i + (lane >> 5); scr[kk * 33 + (lane & 31)] = ok ? __builtin_nontemporal_load(&src[(size_t)(k0 + kk) * ld + scol]) : 0.f; }
  asm volatile("s_waitcnt lgkmcnt(0)" ::: "memory");
  const int c = lane & 7;
#pragma unroll
  for (int j = 0; j < 4; ++j) { const int nn = (lane >> 3) + 8 * j; const LAS float* s = scr + (8 * c) * 33 + nn;
    u32x4 o; o.x = pk2(s[0 * 33], s[1 * 33]); o.y = pk2(s[2 * 33], s[3 * 33]); o.z = pk2(s[4 * 33], s[5 * 33]); o.w = pk2(s[6 * 33], s[7 * 33]);
    *(u32x4*)(dst + (size_t)(n0 + nn) * K + k0 + 8 * c) = o; }
  asm volatile("s_waitcnt lgkmcnt(0)" ::: "memory");
}

DI void norm_mod_rows(const float* __restrict__ X, const float* __restrict__ g, const float* __restrict__ mod, int shift_off, int scale_off, bf16_t* __restrict__ H, int gw, int NGW, int lane) {
  for (int m = gw; m < MTOK; m += 2 * NGW) {
    f32x4 v[2][4]; float s[2];
#pragma unroll
    for (int r = 0; r < 2; ++r) { const int mr = (m + r * NGW < MTOK) ? m + r * NGW : m; const f32x4* xr = (const f32x4*)(X + (size_t)mr * 1024) + lane;
#pragma unroll
      for (int j = 0; j < 4; ++j) v[r][j] = __builtin_nontemporal_load(&xr[64 * j]); }
#pragma unroll
    for (int r = 0; r < 2; ++r) { float a = 0.f;
#pragma unroll
      for (int j = 0; j < 4; ++j) a += (v[r][j][0] * v[r][j][0] + v[r][j][1] * v[r][j][1]) + (v[r][j][2] * v[r][j][2] + v[r][j][3] * v[r][j][3]);
      s[r] = a; }
    s[0] = wave_sum(s[0]); s[1] = wave_sum(s[1]);
#pragma unroll
    for (int r = 0; r < 2; ++r) {
      const int mm = (m + r * NGW < MTOK) ? m + r * NGW : m, b = mm >> 11; const float rinv = rsq_(s[r] * (1.0f / 1024.0f) + EPS);
#pragma unroll
      for (int j = 0; j < 4; ++j) { const int col = 4 * lane + 256 * j;
        const f32x4 g4 = *(const f32x4*)(g + col), sc = *(const f32x4*)(mod + b * 6144 + scale_off + col), sh = *(const f32x4*)(mod + b * 6144 + shift_off + col);
        f32x4 o = v[r][j] * rinv * g4 * (sc + 1.0f) + sh;
        u32x2 w; w.x = pk2(o[0], o[1]); w.y = pk2(o[2], o[3]); *(u32x2*)(H + (size_t)mm * 1024 + col) = w; }
    }
  }
}

#define XB_TMO      128
#define XB_XCNT(j)  (256  + 64 * (j))
#define XB_XSUB(j)  (1280 + 64 * (j))
#define XB_XGEN(j)  (2304 + 64 * (j))
#define XB_TOP      3328
#define XB_TOPGEN   3392
#define XCD_BAR_WORDS 3456
#define XB_SPIN_CAP (1u << 18)
DI unsigned xb_ld(unsigned* p) { return __hip_atomic_load(p, __ATOMIC_RELAXED, __HIP_MEMORY_SCOPE_AGENT); }
DI unsigned xb_add(unsigned* p, unsigned v) { return __hip_atomic_fetch_add(p, v, __ATOMIC_RELAXED, __HIP_MEMORY_SCOPE_AGENT); }
DI unsigned xb_xcc_id() { return (unsigned)__builtin_amdgcn_s_getreg((3 << 11) | 20) & 0xFu; }
#define XB_SPIN(cond, bar) do { unsigned _sp = 0; while (cond) { __builtin_amdgcn_s_sleep(1); \
    if ((++_sp & 255u) == 0u) { if (xb_ld(&(bar)[XB_TMO])) break; if (_sp > XB_SPIN_CAP) { atomicAdd(&(bar)[XB_TMO], 1u); break; } } } } while (0)
struct XcdBarrier { unsigned* bar; unsigned x; volatile LAS unsigned* st; };
DI XcdBarrier xcd_barrier_post(unsigned* bar, volatile LAS unsigned* st) {
  XcdBarrier b; b.bar = bar; b.x = xb_xcc_id(); b.st = st;
  if (threadIdx.x == 0) (void)xb_add(&bar[XB_XCNT(b.x)], 1u);
  return b;
}
DI void xcd_barrier_complete(unsigned* bar, unsigned x, unsigned& nloc, unsigned& nx) {
  const unsigned G = gridDim.x * gridDim.y * gridDim.z;
  unsigned sum, cnt, mine, sp = 0u;
  for (;;) {
    sum = 0u; cnt = 0u; mine = 0u;
#pragma unroll
    for (unsigned j = 0; j < 16; ++j) { const unsigned c = xb_ld(&bar[XB_XCNT(j)]); sum += c; cnt += (c > 0u) ? 1u : 0u; mine = (j == x) ? c : mine; }
    if (sum == G) break;
    __builtin_amdgcn_s_sleep(1);
    if ((++sp & 255u) == 0u) { if (xb_ld(&bar[XB_TMO])) break; if (sp > XB_SPIN_CAP) { atomicAdd(&bar[XB_TMO], 1u); break; } }
  }
  nloc = mine > 0u ? mine : 1u; nx = cnt > 0u ? cnt : 1u;
}
DI void xcd_barrier(const XcdBarrier& b) {
  asm volatile("s_waitcnt vmcnt(0)" ::: "memory");
  __syncthreads();
  if (threadIdx.x == 0) {
    unsigned* bar = b.bar;
    __builtin_amdgcn_s_waitcnt(0);
    unsigned nloc = b.st[0], nx = b.st[1];
    if (nloc == 0u) { xcd_barrier_complete(bar, b.x, nloc, nx); b.st[0] = nloc; b.st[1] = nx; }
    const unsigned old = xb_add(&bar[XB_XSUB(b.x)], 1u);
    const unsigned gen = old / nloc;
    if (old + 1u == (gen + 1u) * nloc) {
      __builtin_amdgcn_fence(__ATOMIC_RELEASE, "agent");
      asm volatile("s_waitcnt vmcnt(0)" ::: "memory");
      const unsigned og = xb_add(&bar[XB_TOP], 1u);
      const unsigned tg = og / nx;
      if (og + 1u == (tg + 1u) * nx) xb_add(&bar[XB_TOPGEN], 1u);
      else XB_SPIN(xb_ld(&bar[XB_TOPGEN]) == tg, bar);
      __builtin_amdgcn_fence(__ATOMIC_ACQUIRE, "agent");
      xb_add(&bar[XB_XGEN(b.x)], 1u);
      asm volatile("s_waitcnt vmcnt(0)" ::: "memory");
    } else {
      XB_SPIN(xb_ld(&bar[XB_XGEN(b.x)]) == gen, bar);
      __builtin_amdgcn_fence(__ATOMIC_ACQUIRE, "agent");
      asm volatile("s_waitcnt vmcnt(0)" ::: "memory");
    }
  }
  __syncthreads();
}

constexpr int NPH = 18;
#ifndef PROBE_PH
#define PROBE_PH -1
#endif
constexpr size_t LDS_BYTES = 151552;

__global__ void __launch_bounds__(512, 2) fwd_kernel(Params p_in) {
  extern __shared__ __attribute__((aligned(16))) unsigned char lds_raw[];
  LAS unsigned char* lds = (LAS unsigned char*)lds_raw;
  cg::grid_group grid = cg::this_grid();
  volatile LAS unsigned* bar_st = (volatile LAS unsigned*)(lds + 151040);
  if (threadIdx.x < 2) bar_st[threadIdx.x] = 0u;
  __syncthreads();
  const XcdBarrier xbar = xcd_barrier_post((unsigned*)(p_in.ws + OFF_CTL), bar_st);
  int probe_reps = 0;
  for (int ph = 0; ph < NPH; ++ph) {
    int tid = threadIdx.x; asm volatile("" : "+v"(tid));
    int bx = blockIdx.x; asm volatile("" : "+s"(bx));
    int G = gridDim.x; asm volatile("" : "+s"(G));
    const __attribute__((address_space(4))) Params* kp = (const __attribute__((address_space(4))) Params*)__builtin_amdgcn_kernarg_segment_ptr(); asm volatile("" : "+s"(kp));
#define p (*kp)
    GAS unsigned char* wsg = (GAS unsigned char*)p.ws; asm volatile("" : "+s"(wsg)); unsigned char* ws = (unsigned char*)wsg;
    const int lane = tid & 63, wave = __builtin_amdgcn_readfirstlane(tid >> 6);
    const int gw = bx * 8 + wave, NGW = G * 8;
    float* mod = (float*)(ws + OFF_MOD);
    float* cosT = (float*)(ws + OFF_COS); float* sinT = (float*)(ws + OFF_SIN);
    pg8::Gemm g{nullptr, nullptr, 0, 0, 0}; int epi = -1; bool sync = true;
    switch (ph) {
      case 0: {
        LAS float* lf = (LAS float*)lds;
        LAS float* scr = lf + wave * (64 * 33);
        LAS float* sc = lf + 16896;
        if (bx < 192) {
#pragma unroll 8
          for (int idx = tid; idx < 16384; idx += 512) { const int b = idx >> 10, k = idx & 1023; const float cv = p.c[idx]; sc[k * 16 + b] = cv * __builtin_amdgcn_rcpf(1.0f + __expf(-cv)); } }
        bf16_t* WinN = (bf16_t*)(ws + OFF_WINN); bf16_t* WinT = (bf16_t*)(ws + OFF_WINT);
        constexpr int I1 = 256, I2 = 512, I3 = 1024, I4 = 128, I5 = 64, I6 = 16, I7 = 48, I8 = 256, I9 = 512, I10 = 192, I11 = 64, I12 = 64, I13 = 512, I14 = 512, I15 = 512, I16 = 2048, I17 = 2048;
        constexpr int NIT = I1 + I2 + I3 + I4 + I5 + I6 + I7 + I8 + I9 + I10 + I11 + I12 + I13 + I14 + I15 + I16 + I17;
        for (int it = gw; it < NIT; it += NGW) {
          int r = it;
          if (r < I1) { tr_item(p.w_in, INW, C_GQ, 64, 512, 512, 1024, WinN, scr, r, lane, true); continue; } r -= I1;
          if (r < I2) { tr_item(p.w_in, INW, C_GG, 64, 1024, 1024, 1024, WinN + (size_t)512 * 1024, scr, r, lane); continue; } r -= I2;
          if (r < I3) { tr_item(p.w_in, INW, C_MG, 64, 2048, 2048, 1024, WinN + (size_t)1536 * 1024, scr, r, lane); continue; } r -= I3;
          if (r < I4) { tr_item(p.w_in, INW, C_CQ, 64, 256, 256, 1024, WinN + (size_t)3584 * 1024, scr, r, lane); continue; } r -= I4;
          if (r < I5) { tr_item(p.w_in, INW, C_CKV, 64, 128, 128, 1024, WinN + (size_t)3840 * 1024, scr, r, lane); continue; } r -= I5;
          if (r < I6) { tr_item(p.w_in, INW, C_KPE, 64, 32, 32, 1024, WinN + (size_t)3968 * 1024, scr, r, lane); continue; } r -= I6;
          if (r < I7) { tr_item(p.w_in, INW, C_GA, 64, 16, 96, 1024, WinN + (size_t)4000 * 1024, scr, r, lane); continue; } r -= I7;
          if (r < I8) { tr_item(p.w_in, INW, C_GK, 64, 512, 512, 1024, WinT, scr, r, lane); continue; } r -= I8;
          if (r < I9) { tr_item(p.w_in, INW, C_GV, 64, 1024, 1024, 1024, WinT + (size_t)512 * 1024, scr, r, lane); continue; } r -= I9;
          if (r < I10) { tr_item(p.w_uq, 1536, 0, 64, 1536, 1536, 256, (bf16_t*)(ws + OFF_WUQT), scr, r, lane); continue; } r -= I10;
          if (r < I11) { tr_item(p.w_ukv, 2048, 0, 128, 1024, 1024, 128, (bf16_t*)(ws + OFF_WUKT), scr, r, lane); continue; } r -= I11;
          if (r < I12) { tr_item(p.w_ukv, 2048, 64, 128, 1024, 1024, 128, (bf16_t*)(ws + OFF_WUVT), scr, r, lane); continue; } r -= I12;
          if (r < I13) { tr_item(p.gla_w_o, 1024, 0, 64, 1024, 1024, 1024, (bf16_t*)(ws + OFF_WGOT), scr, r, lane); continue; } r -= I13;
          if (r < I14) { tr_item(p.mla_w_o, 1024, 0, 64, 1024, 1024, 1024, (bf16_t*)(ws + OFF_WMOT), scr, r, lane); continue; } r -= I14;
          if (r < I15) { tr_item(p.w_out, 1024, 0, 64, 1024, 1024, 1024, (bf16_t*)(ws + OFF_WOUTT), scr, r, lane); continue; } r -= I15;
          if (r < I16) { tr_item(p.w1, 4096, 0, 64, 4096, 4096, 1024, (bf16_t*)(ws + OFF_W1T), scr, r, lane); continue; } r -= I16;
          tr_item(p.w2, 1024, 0, 64, 1024, 1024, 4096, (bf16_t*)(ws + OFF_W2T), scr, r, lane);
        }
        for (int idx = bx * 512 + tid; idx < MTOK * 16; idx += G * 512) ((float*)(ws + OFF_KSS))[idx] = 0.f;
        for (int idx = bx * 512 + tid; idx < MTOK; idx += G * 512) { ((float*)(ws + OFF_CQSS))[idx] = 0.f; ((float*)(ws + OFF_CKVSS))[idx] = 0.f; }
#pragma unroll 4
        for (int idx = bx * 512 + tid; idx < MTOK * 16; idx += G * 512) {
          const int m = idx >> 4, i = idx & 15;
          const float freq = exp2f(-(float)i * 0.83048202372184058f);
          const float ang = (float)p.pos[m] * freq;
          double rev = (double)ang * 0.15915494309189535; rev -= rint(rev);
          const float fr = (float)rev;
          cosT[idx] = __builtin_amdgcn_cosf(fr); sinT[idx] = __builtin_amdgcn_sinf(fr);
        }
        __syncthreads();
        for (int u = bx; u < 192; u += G) {
          const int col = u * 32 + (lane & 31), k0 = wave * 128 + (lane >> 5);
          float acc[16];
#pragma unroll
          for (int b = 0; b < 16; ++b) acc[b] = 0.f;
#pragma unroll 16
          for (int i = 0; i < 64; ++i) {
            const int k = k0 + 2 * i;
            const float w = __builtin_nontemporal_load(&p.w_ada[(size_t)k * 6144 + col]);
            const LAS f32x4* s4 = (const LAS f32x4*)(sc + k * 16);
#pragma unroll
            for (int q = 0; q < 4; ++q) { const f32x4 sv4 = s4[q]; acc[4 * q] += sv4[0] * w; acc[4 * q + 1] += sv4[1] * w; acc[4 * q + 2] += sv4[2] * w; acc[4 * q + 3] += sv4[3] * w; }
          }
          LAS float* red = lf;
#pragma unroll
          for (int b = 0; b < 16; ++b) { const float t = xor_add32(acc[b]); if (lane < 32) red[(wave * 16 + b) * 32 + lane] = t; }
          __syncthreads();
          { const int o = tid; const int b = o >> 5, l = o & 31; float sum = p.b_ada[u * 32 + l];
#pragma unroll
            for (int w = 0; w < 8; ++w) sum += red[(w * 16 + b) * 32 + l];
            mod[b * 6144 + u * 32 + l] = sum; }
          __syncthreads();
        }
      } break;
      case 1: norm_mod_rows(p.x, p.norm1_g, mod, 0, 1024, (bf16_t*)(ws + OFF_HB), gw, NGW, lane); break;
      case 2: g = pg8::Gemm{(const bf16_t*)(ws + OFF_HB), (const bf16_t*)(ws + OFF_WINN), MTOK, 4096, 1024}; epi = EPI_PROJN; sync = false; break;
      case 3: g = pg8::Gemm{(const bf16_t*)(ws + OFF_WINT), (const bf16_t*)(ws + OFF_HB), 1536, MTOK, 1024}; epi = EPI_PROJT; break;
      case 4: {
        const float* KPE = (const float*)(ws + OFF_KPE); bf16_t* KpeR = (bf16_t*)(ws + OFF_KPER); float* KpeSS = (float*)(ws + OFF_KPESS);
        for (int idx = bx * 512 + tid; idx < MTOK * 16; idx += G * 512) {
          const int m = idx >> 4, i = idx & 15;
          const float x1 = KPE[(size_t)m * 32 + i], x2 = KPE[(size_t)m * 32 + 16 + i];
          const float y1 = x1 * p.kn_g[64 + i], y2 = x2 * p.kn_g[80 + i]; const float c = cosT[idx], sn = sinT[idx];
          KpeR[(size_t)m * 32 + i] = f2bf(y1 * c - y2 * sn); KpeR[(size_t)m * 32 + 16 + i] = f2bf(y2 * c + y1 * sn);
          float ss = row16_sum(x1 * x1 + x2 * x2);
          if (i == 0) KpeSS[m] = ss;
        }
        bf16_t* KT = (bf16_t*)(ws + OFF_KT); const float* ALR = (const float*)(ws + OFF_ALR); float* Decay = (float*)(ws + OFF_DECAY);
        for (int c = bx; c < 512; c += G) {
          const int m0 = c * 64, pc = tid & 7, fl = tid >> 3;
          f32x4 alr[8][4];
#pragma unroll
          for (int j = 0; j < 8; ++j)
#pragma unroll
            for (int q = 0; q < 4; ++q) alr[j][q] = *(const f32x4*)(ALR + (size_t)(m0 + 8 * pc + j) * 16 + 4 * q);
          for (int rb = 0; rb < 8; ++rb) {
            const int f = rb * 64 + fl;
            float w[16];
#pragma unroll
            for (int r = 0; r < 16; ++r) w[r] = p.w_alpha[r * 512 + f];
            const float ba = p.b_alpha[f];
            u32x4* kp = (u32x4*)(KT + ((size_t)c * 512 + f) * 64 + 8 * pc);
            float kv[8]; unpack8(*kp, kv);
            float la[8]; float tot = 0.f;
#pragma unroll
            for (int j = 0; j < 8; ++j) { float z = ba;
#pragma unroll
              for (int q = 0; q < 4; ++q) z += alr[j][q][0] * w[4 * q] + alr[j][q][1] * w[4 * q + 1] + alr[j][q][2] * w[4 * q + 2] + alr[j][q][3] * w[4 * q + 3];
              la[j] = (fminf(z, 0.f) - __logf(1.0f + __expf(-fabsf(z)))) * (1.0f / 16.0f); tot += la[j]; }
            float sfx = tot;
            { float t1 = __int_as_float(__builtin_amdgcn_ds_bpermute(((lane + 1) & 63) << 2, __float_as_int(sfx))); if (pc + 1 < 8) sfx += t1;
              float t2 = __int_as_float(__builtin_amdgcn_ds_bpermute(((lane + 2) & 63) << 2, __float_as_int(sfx))); if (pc + 2 < 8) sfx += t2;
              float t4 = __int_as_float(__builtin_amdgcn_ds_bpermute(((lane + 4) & 63) << 2, __float_as_int(sfx))); if (pc + 4 < 8) sfx += t4; }
            float rev = sfx - tot;
#pragma unroll
            for (int j = 7; j >= 0; --j) { kv[j] *= __expf(rev); rev += la[j]; }
            if (PROBE_PH == 4 && probe_reps == 0) *(u32x4*)((bf16_t*)(ws + SL5) + ((size_t)c * 512 + f) * 64 + 8 * pc) = pack8(kv); else *kp = pack8(kv);
            if (pc == 0) Decay[c * 512 + f] = __expf(rev);
          }
        }
      } break;
      case 5: {
        const bf16_t* KdT = (const bf16_t*)(ws + OFF_KT); const bf16_t* VT = (const bf16_t*)(ws + OFF_VT); const float* Decay = (const float*)(ws + OFF_DECAY);
        float* SL = (float*)(ws + 438 * MB);
        constexpr int A_KO = 0, A_DO = 18432, A_BF = 18944;
        const int r32 = lane & 31, hi = lane >> 5;
        for (int u = bx; u < 256; u += G) {
          const int bhu = u >> 2, seg = u & 3, b = bhu >> 2, h = bhu & 3, n0 = 8 * seg, nend = n0 + 8;
          if (seg == 3) continue;
          f32x16 S[4];
#pragma unroll
          for (int kb = 0; kb < 4; ++kb)
#pragma unroll
            for (int r = 0; r < 16; ++r) S[kb][r] = 0.f;
          u32x4 stK[2]; float sd = 0.f, dprod = 1.f; bf16x8 vcur[4], vnext[4];
          const bf16_t* vrow = VT + ((size_t)(b * 32) * 1024 + h * 256 + 32 * wave + r32) * 64 + 8 * hi;
#define GA_LOAD(n_) do { \
            _Pragma("unroll") for (int i = 0; i < 2; ++i) { const int id = tid + 512 * i; stK[i] = *(const u32x4*)(KdT + ((size_t)(b * 32 + (n_)) * 512 + h * 128 + (id >> 3)) * 64 + (id & 7) * 8); } \
            if (tid < 128) sd = Decay[(b * 32 + (n_)) * 512 + h * 128 + tid]; \
            _Pragma("unroll") for (int ts = 0; ts < 4; ++ts) vnext[ts] = *(const bf16x8*)(vrow + (size_t)(n_) * 65536 + 16 * ts); } while (0)
#define GA_STORE(buf_) do { LAS unsigned char* bs_ = lds + (buf_) * A_BF; \
            _Pragma("unroll") for (int i = 0; i < 2; ++i) { const int id = tid + 512 * i; *(LAS u32x4*)(bs_ + A_KO + (id >> 3) * 144 + (id & 7) * 16) = stK[i]; } \
            if (tid < 128) { *(LAS float*)(bs_ + A_DO + tid * 4) = sd; dprod *= sd; } } while (0)
          LDS_BARRIER();
          GA_LOAD(n0); GA_STORE(0);
#pragma unroll
          for (int ts = 0; ts < 4; ++ts) vcur[ts] = vnext[ts];
          GA_LOAD(n0 + 1);
          LDS_BARRIER();
          for (int n = n0; n < nend; ++n) {
            const LAS unsigned char* base = lds + (n & 1) * A_BF;
#pragma unroll
            for (int kb = 0; kb < 4; ++kb)
#pragma unroll
              for (int g4 = 0; g4 < 4; ++g4) { const f32x4 d4 = *(const LAS f32x4*)(base + A_DO + (32 * kb + 8 * g4 + 4 * hi) * 4);
#pragma unroll
                for (int j = 0; j < 4; ++j) S[kb][4 * g4 + j] *= d4[j]; }
#pragma unroll
            for (int ts = 0; ts < 4; ++ts)
#pragma unroll
              for (int kb = 0; kb < 4; ++kb) { const bf16x8 afr = *(const LAS bf16x8*)(base + A_KO + (32 * kb + r32) * 144 + (16 * ts + 8 * hi) * 2);
                S[kb] = __builtin_amdgcn_mfma_f32_32x32x16_bf16(afr, vcur[ts], S[kb], 0, 0, 0); }
            if (n + 1 < nend) GA_STORE((n + 1) & 1);
#pragma unroll
            for (int ts = 0; ts < 4; ++ts) vcur[ts] = vnext[ts];
            if (n + 2 < nend) GA_LOAD(n + 2);
            LDS_BARRIER();
          }
          f32x4* slp = (f32x4*)(SL + ((size_t)((bhu * 3 + seg) * 8 + wave) * 64 + lane) * 64);
#pragma unroll
          for (int kb = 0; kb < 4; ++kb)
#pragma unroll
            for (int g4 = 0; g4 < 4; ++g4) slp[kb * 4 + g4] = (f32x4){S[kb][4 * g4], S[kb][4 * g4 + 1], S[kb][4 * g4 + 2], S[kb][4 * g4 + 3]};
          if (tid < 128) ((float*)(ws + 462 * MB))[(bhu * 3 + seg) * 128 + tid] = dprod;
#undef GA_LOAD
#undef GA_STORE
        }
      } break;
      case 6: {
        const bf16_t* KdT = (const bf16_t*)(ws + OFF_KT); const bf16_t* VT = (const bf16_t*)(ws + OFF_VT); const bf16_t* Qg = (const bf16_t*)(ws + OFF_QG);
        const float* Decay = (const float*)(ws + OFF_DECAY); const bf16_t* Gs = (const bf16_t*)(ws + OFF_GS); bf16_t* Og = (bf16_t*)(ws + OFF_OG);
        constexpr int G_KOFF = 0, G_QOFF = 18432, G_DOFF = 35840, G_BUF = 36352, G_SS = 72704, G_OT = 76800;
        const int r32 = lane & 31, hi = lane >> 5;
        const float* SL = (const float*)(ws + 438 * MB);
        for (int u = bx; u < 256; u += G) {
          const int bhu = u >> 2, seg = u & 3, b = bhu >> 2, h = bhu & 3, n0 = 8 * seg, nend = n0 + 8;
          int tid_u = tid; asm volatile("" : "+v"(tid_u));
          const int tid = tid_u, lane = tid & 63, r32 = lane & 31, hi = lane >> 5;
          f32x16 S[4];
#pragma unroll
          for (int kb = 0; kb < 4; ++kb)
#pragma unroll
            for (int r = 0; r < 16; ++r) S[kb][r] = 0.f;
          for (int jp = 0; jp < seg; ++jp) {
            const f32x4* slp = (const f32x4*)(SL + ((size_t)((bhu * 3 + jp) * 8 + wave) * 64 + lane) * 64);
#pragma unroll
            for (int kb = 0; kb < 4; ++kb) {
              f32x4 d[4];
              const float* dp = (const float*)(ws + 462 * MB) + (bhu * 3 + jp) * 128 + 32 * kb + 4 * hi;
#pragma unroll
              for (int g4 = 0; g4 < 4; ++g4) d[g4] = *(const f32x4*)(dp + 8 * g4);
#pragma unroll
              for (int g4 = 0; g4 < 4; ++g4) { const f32x4 sl4 = slp[kb * 4 + g4];
#pragma unroll
                for (int j = 0; j < 4; ++j) S[kb][4 * g4 + j] = d[g4][j] * S[kb][4 * g4 + j] + sl4[j]; }
            }
          }
          u32x4 stK[2], stQ[2]; float sd = 0.f; bf16x8 vcur[4], vnext[4];
          f32x4 gnr[4];
#pragma unroll
          for (int g4 = 0; g4 < 4; ++g4) gnr[g4] = *(const f32x4*)(p.gla_gn + 32 * wave + 8 * g4 + 4 * hi);
          const bf16_t* vrow = VT + ((size_t)(b * 32) * 1024 + h * 256 + 32 * wave + r32) * 64 + 8 * hi;
#define GLA_LOAD(n_) do { const int m0_ = b * 2048 + 64 * (n_); \
            _Pragma("unroll") for (int i = 0; i < 2; ++i) { const int id = tid + 512 * i; stK[i] = *(const u32x4*)(KdT + ((size_t)(b * 32 + (n_)) * 512 + h * 128 + (id >> 3)) * 64 + (id & 7) * 8); } \
            _Pragma("unroll") for (int i = 0; i < 2; ++i) { const int id = tid + 512 * i; stQ[i] = *(const u32x4*)(Qg + (size_t)(m0_ + (id >> 4)) * 512 + h * 128 + (id & 15) * 8); } \
            if (tid < 128) sd = Decay[(b * 32 + (n_)) * 512 + h * 128 + tid]; \
            _Pragma("unroll") for (int ts = 0; ts < 4; ++ts) vnext[ts] = *(const bf16x8*)(vrow + (size_t)(n_) * 65536 + 16 * ts); } while (0)
#define GLA_STORE(buf_) do { LAS unsigned char* bs_ = lds + (buf_) * G_BUF; \
            _Pragma("unroll") for (int i = 0; i < 2; ++i) { const int id = tid + 512 * i; *(LAS u32x4*)(bs_ + G_KOFF + (id >> 3) * 144 + (id & 7) * 16) = stK[i]; } \
            _Pragma("unroll") for (int i = 0; i < 2; ++i) { const int id = tid + 512 * i; *(LAS u32x4*)(bs_ + G_QOFF + (id >> 4) * 272 + (id & 15) * 16) = stQ[i]; } \
            if (tid < 128) *(LAS float*)(bs_ + G_DOFF + tid * 4) = sd; } while (0)
          LDS_BARRIER();
          GLA_LOAD(n0); GLA_STORE(0);
#pragma unroll
          for (int ts = 0; ts < 4; ++ts) vcur[ts] = vnext[ts];
          GLA_LOAD(n0 + 1);
          LDS_BARRIER();
          for (int n = n0; n < nend; ++n) {
            const LAS unsigned char* base = lds + (n & 1) * G_BUF;
            const int m0 = b * 2048 + 64 * n;
            u32x4 gsr[4];
#pragma unroll
            for (int i = 0; i < 4; ++i) { const int id = tid + 512 * i; gsr[i] = __builtin_nontemporal_load((const u32x4*)(Gs + (size_t)(m0 + (id >> 5)) * 1024 + h * 256 + (id & 31) * 8)); }
#pragma unroll
            for (int kb = 0; kb < 4; ++kb)
#pragma unroll
              for (int g4 = 0; g4 < 4; ++g4) { const f32x4 d4 = *(const LAS f32x4*)(base + G_DOFF + (32 * kb + 8 * g4 + 4 * hi) * 4);
#pragma unroll
                for (int j = 0; j < 4; ++j) S[kb][4 * g4 + j] *= d4[j]; }
#pragma unroll
            for (int ts = 0; ts < 4; ++ts)
#pragma unroll
              for (int kb = 0; kb < 4; ++kb) { const bf16x8 afr = *(const LAS bf16x8*)(base + G_KOFF + (32 * kb + r32) * 144 + (16 * ts + 8 * hi) * 2);
                S[kb] = __builtin_amdgcn_mfma_f32_32x32x16_bf16(afr, vcur[ts], S[kb], 0, 0, 0); }
            f32x16 oT[2];
#pragma unroll
            for (int r = 0; r < 16; ++r) { oT[0][r] = 0.f; oT[1][r] = 0.f; }
#pragma unroll
            for (int kb = 0; kb < 4; ++kb)
#pragma unroll
              for (int s2 = 0; s2 < 2; ++s2) {
                u32x4 w; w.x = pk2(S[kb][8 * s2], S[kb][8 * s2 + 1]); w.y = pk2(S[kb][8 * s2 + 2], S[kb][8 * s2 + 3]); w.z = pk2(S[kb][8 * s2 + 4], S[kb][8 * s2 + 5]); w.w = pk2(S[kb][8 * s2 + 6], S[kb][8 * s2 + 7]);
                const bf16x8 sp = __builtin_bit_cast(bf16x8, w);
#pragma unroll
                for (int tb = 0; tb < 2; ++tb) { const bf16x8 qfr = *(const LAS bf16x8*)(base + G_QOFF + (32 * tb + r32) * 272 + (32 * kb + 16 * s2 + 8 * hi) * 2);
                  oT[tb] = __builtin_amdgcn_mfma_f32_32x32x16_bf16(sp, qfr, oT[tb], 0, 0, 0); }
              }
            LAS float* ssb = (LAS float*)(lds + G_SS) + (n & 1) * 512;
#pragma unroll
            for (int tb = 0; tb < 2; ++tb) { float ss = 0.f;
#pragma unroll
              for (int r = 0; r < 16; ++r) ss += oT[tb][r] * oT[tb][r];
              ss = xor_add32(ss); if (hi == 0) ssb[wave * 64 + 32 * tb + r32] = ss; }
            LDS_BARRIER();
#pragma unroll
            for (int tb = 0; tb < 2; ++tb) { float tot = 0.f;
#pragma unroll
              for (int w = 0; w < 8; ++w) tot += ssb[w * 64 + 32 * tb + r32];
              const float rinv = rsq_(tot * (1.0f / 256.0f) + EPS);
#pragma unroll
              for (int g4 = 0; g4 < 4; ++g4) { const int dv = 32 * wave + 8 * g4 + 4 * hi; const f32x4 gn4 = gnr[g4];
                u32x2 o; o.x = pk2(oT[tb][4 * g4] * rinv * gn4[0], oT[tb][4 * g4 + 1] * rinv * gn4[1]); o.y = pk2(oT[tb][4 * g4 + 2] * rinv * gn4[2], oT[tb][4 * g4 + 3] * rinv * gn4[3]);
                *(LAS u32x2*)(lds + G_OT + (32 * tb + r32) * 528 + dv * 2) = o; } }
            if (n + 1 < nend) GLA_STORE((n + 1) & 1);
#pragma unroll
            for (int ts = 0; ts < 4; ++ts) vcur[ts] = vnext[ts];
            if (n + 2 < nend) GLA_LOAD(n + 2);
            LDS_BARRIER();
#pragma unroll
            for (int i = 0; i < 4; ++i) { const int id = tid + 512 * i; const int row = id >> 5, pc = id & 31;
              float o8[8], g8[8]; unpack8(*(const LAS u32x4*)(lds + G_OT + row * 528 + pc * 16), o8); unpack8(gsr[i], g8);
#pragma unroll
              for (int j = 0; j < 8; ++j) o8[j] *= g8[j];
              *(u32x4*)(Og + (size_t)(m0 + row) * 1024 + h * 256 + pc * 8) = pack8(o8); }
          }
#undef GLA_LOAD
#undef GLA_STORE
        }
      } break;
      case 7: g = pg8::Gemm{(const bf16_t*)(ws + OFF_OG), (const bf16_t*)(ws + OFF_WGOT), MTOK, 1024, 1024}; epi = EPI_YA; break;
      case 8: g = pg8::Gemm{(const bf16_t*)(ws + OFF_CQN), (const bf16_t*)(ws + OFF_WUQT), MTOK, 1536, 256}; epi = EPI_QUP; sync = false; break;
      case 9: g = pg8::Gemm{(const bf16_t*)(ws + OFF_CKVN), (const bf16_t*)(ws + OFF_WUKT), MTOK, 1024, 128}; epi = EPI_KUP; sync = false; break;
      case 10: g = pg8::Gemm{(const bf16_t*)(ws + OFF_WUVT), (const bf16_t*)(ws + OFF_CKVN), 1024, MTOK, 128}; epi = EPI_VUPT; break;
      case 11: sync = false; break;
      case 12: {
        const bf16_t* Q = (const bf16_t*)(ws + OFF_Q); const bf16_t* Kn = (const bf16_t*)(ws + OFF_KNOPE); const bf16_t* KpeR = (const bf16_t*)(ws + OFF_KPER);
        const bf16_t* VmT = (const bf16_t*)(ws + OFF_VMT); const float* KSS = (const float*)(ws + OFF_KSS); const float* KpeSS = (const float*)(ws + OFF_KPESS); bf16_t* Om = (bf16_t*)(ws + OFF_OM);
        constexpr int A_KOFF = 0, A_VOFF = 13312, A_ROFF = 22528, A_BUF = 22784;
        const int r32 = lane & 31, hi = lane >> 5;
        const int pi = (r32 & ~12) | ((r32 & 4) << 1) | ((r32 & 8) >> 1);
        float sbound;
        { float gq = fabsf(p.qn_g[lane]), gk = fabsf(p.kn_g[lane]);
          if (lane < 32) { gq = fmaxf(gq, fabsf(p.qn_g[64 + lane])); gk = fmaxf(gk, fabsf(p.kn_g[64 + lane])); }
          gq = wave_max(gq); gk = wave_max(gk);
          sbound = fminf(9.797958971132712f * 1.4426950408889634f * gq * gk, 60.0f); }
        constexpr int A_GT = 46080;
        __syncthreads();
        if (tid < 96) *(LAS float*)(lds + A_GT + tid * 4) = p.qn_g[tid] * (tid < 64 ? p.kn_g[tid] : 1.0f);
        __syncthreads();
        for (int bh = bx; bh < 256; bh += G) {
          const int b = bh >> 4, h = bh & 15;
          for (int qb = 7; qb >= 0; --qb) {
            const int NT = 4 * qb + 4, cw = 4 * qb + (wave >> 1);
            const int qrow = b * 2048 + 256 * qb + 32 * wave + r32;
            u32x4 sk, sv, sr = {0u, 0u, 0u, 0u}; float srk = 0.f, srk2 = 0.f;
#define ATT_LOAD(t_) do { const int mk_ = b * 2048 + 64 * (t_); \
              sk = *(const u32x4*)(Kn + ((size_t)(b * 16 + h) * 2048 + 64 * (t_) + (tid >> 3)) * 64 + (tid & 7) * 8); \
              if (tid < 256) sr = *(const u32x4*)(KpeR + (size_t)(mk_ + (tid >> 2)) * 32 + (tid & 3) * 8); \
              else if (tid < 320) { srk = KSS[(mk_ + tid - 256) * 16 + h]; srk2 = KpeSS[mk_ + tid - 256]; } \
              sv = *(const u32x4*)(VmT + ((size_t)(b * 32 + (t_)) * 1024 + h * 64 + (tid >> 3)) * 64 + (tid & 7) * 8); } while (0)
#define ATT_STORE(buf_) do { LAS unsigned char* bs_ = lds + (buf_) * A_BUF; \
              *(LAS u32x4*)(bs_ + A_KOFF + (tid >> 3) * 208 + (tid & 7) * 16) = sk; \
              if (tid < 256) *(LAS u32x4*)(bs_ + A_KOFF + (tid >> 2) * 208 + 128 + (tid & 3) * 16) = sr; \
              else if (tid < 320) *(LAS float*)(bs_ + A_ROFF + (tid - 256) * 4) = rsq_((srk + srk2) * (1.0f / 96.0f) + EPS); \
              *(LAS u32x4*)(bs_ + A_VOFF + (tid >> 3) * 144 + (tid & 7) * 16) = sv; } while (0)
            ATT_LOAD(0);
            bf16x8 qf[6];
            {
              int hiq = hi; asm volatile("" : "+v"(hiq));
              u32x4 qraw[6]; float ss = 0.f;
#pragma unroll
              for (int ds = 0; ds < 6; ++ds) qraw[ds] = __builtin_nontemporal_load((const u32x4*)(Q + (size_t)qrow * 1536 + h * 96 + 16 * ds + 8 * hiq));
              const float* cp = cosT + (size_t)qrow * 16 + 8 * hiq; const float* sp = sinT + (size_t)qrow * 16 + 8 * hiq;
              const f32x4 c0 = *(const f32x4*)cp, c1 = *(const f32x4*)(cp + 4), n0 = *(const f32x4*)sp, n1 = *(const f32x4*)(sp + 4);
#pragma unroll
              for (int ds = 0; ds < 6; ++ds) { float t8[8]; unpack8(qraw[ds], t8);
#pragma unroll
                for (int j = 0; j < 8; ++j) ss += t8[j] * t8[j]; }
              ss = xor_add32(ss);
              const float rinv = rsq_(ss * (1.0f / 96.0f) + EPS) * (0.10206207261596575f * 1.4426950408889634f);
              const LAS float* gt = (const LAS float*)(lds + A_GT) + 8 * hiq;
#pragma unroll
              for (int ds = 0; ds < 4; ++ds) {
                const f32x4 a0 = *(const LAS f32x4*)(gt + 16 * ds), a1 = *(const LAS f32x4*)(gt + 16 * ds + 4);
                float t8[8]; unpack8(qraw[ds], t8);
#pragma unroll
                for (int j = 0; j < 4; ++j) { t8[j] *= rinv * a0[j]; t8[4 + j] *= rinv * a1[j]; }
                qf[ds] = __builtin_bit_cast(bf16x8, pack8(t8));
              }
              {
                const f32x4 g10 = *(const LAS f32x4*)(gt + 64), g11 = *(const LAS f32x4*)(gt + 68), g20 = *(const LAS f32x4*)(gt + 80), g21 = *(const LAS f32x4*)(gt + 84);
                float x1[8], x2[8]; unpack8(qraw[4], x1); unpack8(qraw[5], x2);
#pragma unroll
                for (int j = 0; j < 8; ++j) { const float y1 = x1[j] * rinv * (j < 4 ? g10[j & 3] : g11[j & 3]), y2 = x2[j] * rinv * (j < 4 ? g20[j & 3] : g21[j & 3]);
                  const float c = (j < 4 ? c0[j & 3] : c1[j & 3]), sn = (j < 4 ? n0[j & 3] : n1[j & 3]);
                  x1[j] = y1 * c - y2 * sn; x2[j] = y2 * c + y1 * sn; }
                qf[4] = __builtin_bit_cast(bf16x8, pack8(x1)); qf[5] = __builtin_bit_cast(bf16x8, pack8(x2));
              }
            }
            f32x16 o0, o1;
#pragma unroll
            for (int r = 0; r < 16; ++r) { o0[r] = 0.f; o1[r] = 0.f; }
            float l = 0.f;
            ATT_STORE(0); LDS_BARRIER();
            for (int t = 0; t < NT; ++t) {
              if (t + 1 < NT) ATT_LOAD(t + 1);
              if (t <= cw) {
                const LAS unsigned char* base = lds + (t & 1) * A_BUF;
                f32x16 s0, s1;
#pragma unroll
                for (int r = 0; r < 16; ++r) { s0[r] = 0.f; s1[r] = 0.f; }
                bf16x8 ka[3], kc[3], va[4], vc[4];
#pragma unroll
                for (int hf = 0; hf < 2; ++hf) {
#pragma unroll
                  for (int d3 = 0; d3 < 3; ++d3) { const int ds = 3 * hf + d3; ka[d3] = *(const LAS bf16x8*)(base + A_KOFF + pi * 208 + ds * 32 + hi * 16); kc[d3] = *(const LAS bf16x8*)(base + A_KOFF + (32 + pi) * 208 + ds * 32 + hi * 16); }
                  __builtin_amdgcn_sched_barrier(0);
#pragma unroll
                  for (int d3 = 0; d3 < 3; ++d3) {
                    s0 = __builtin_amdgcn_mfma_f32_32x32x16_bf16(ka[d3], qf[3 * hf + d3], s0, 0, 0, 0);
                    s1 = __builtin_amdgcn_mfma_f32_32x32x16_bf16(kc[d3], qf[3 * hf + d3], s1, 0, 0, 0);
                  }
                }
#pragma unroll
                for (int s4 = 0; s4 < 4; ++s4) { va[s4] = *(const LAS bf16x8*)(base + A_VOFF + r32 * 144 + (16 * s4 + 8 * hi) * 2); vc[s4] = *(const LAS bf16x8*)(base + A_VOFF + (32 + r32) * 144 + (16 * s4 + 8 * hi) * 2); }
                const LAS f32x4* rk = (const LAS f32x4*)(base + A_ROFF);
                const f32x4 k00 = rk[2 * hi], k01 = rk[2 * hi + 1], k02 = rk[4 + 2 * hi], k03 = rk[4 + 2 * hi + 1];
                const f32x4 k10 = rk[8 + 2 * hi], k11 = rk[8 + 2 * hi + 1], k12 = rk[12 + 2 * hi], k13 = rk[12 + 2 * hi + 1];
#pragma unroll
                for (int j = 0; j < 4; ++j) {
                  s0[j] = __builtin_amdgcn_exp2f(s0[j] * k00[j] - sbound); s0[4 + j] = __builtin_amdgcn_exp2f(s0[4 + j] * k01[j] - sbound);
                  s0[8 + j] = __builtin_amdgcn_exp2f(s0[8 + j] * k02[j] - sbound); s0[12 + j] = __builtin_amdgcn_exp2f(s0[12 + j] * k03[j] - sbound);
                  s1[j] = __builtin_amdgcn_exp2f(s1[j] * k10[j] - sbound); s1[4 + j] = __builtin_amdgcn_exp2f(s1[4 + j] * k11[j] - sbound);
                  s1[8 + j] = __builtin_amdgcn_exp2f(s1[8 + j] * k12[j] - sbound); s1[12 + j] = __builtin_amdgcn_exp2f(s1[12 + j] * k13[j] - sbound); }
                float ps = 0.f;
#pragma unroll
                for (int r = 0; r < 16; ++r) ps += s0[r] + s1[r];
                l += ps;
#pragma unroll
                for (int s4 = 0; s4 < 4; ++s4) {
                  u32x4 w;
                  if (s4 == 0) { w.x = pk2(s0[0], s0[1]); w.y = pk2(s0[2], s0[3]); w.z = pk2(s0[4], s0[5]); w.w = pk2(s0[6], s0[7]); }
                  else if (s4 == 1) { w.x = pk2(s0[8], s0[9]); w.y = pk2(s0[10], s0[11]); w.z = pk2(s0[12], s0[13]); w.w = pk2(s0[14], s0[15]); }
                  else if (s4 == 2) { w.x = pk2(s1[0], s1[1]); w.y = pk2(s1[2], s1[3]); w.z = pk2(s1[4], s1[5]); w.w = pk2(s1[6], s1[7]); }
                  else { w.x = pk2(s1[8], s1[9]); w.y = pk2(s1[10], s1[11]); w.z = pk2(s1[12], s1[13]); w.w = pk2(s1[14], s1[15]); }
                  const bf16x8 pf = __builtin_bit_cast(bf16x8, w);
                  o0 = __builtin_amdgcn_mfma_f32_32x32x16_bf16(va[s4], pf, o0, 0, 0, 0);
                  o1 = __builtin_amdgcn_mfma_f32_32x32x16_bf16(vc[s4], pf, o1, 0, 0, 0);
                }
              }
              if (t + 1 < NT) ATT_STORE((t + 1) & 1);
              LDS_BARRIER();
            }
            l = xor_add32(l);
            const float li = __builtin_amdgcn_rcpf(l);
            {
              LAS unsigned char* stg = lds + 49152 + wave * 4096;
#pragma unroll
              for (int g4 = 0; g4 < 4; ++g4) {
                u32x2 w0, w1; w0.x = pk2(o0[4 * g4] * li, o0[4 * g4 + 1] * li); w0.y = pk2(o0[4 * g4 + 2] * li, o0[4 * g4 + 3] * li);
                w1.x = pk2(o1[4 * g4] * li, o1[4 * g4 + 1] * li); w1.y = pk2(o1[4 * g4 + 2] * li, o1[4 * g4 + 3] * li);
                *(LAS u32x2*)(stg + r32 * 128 + (8 * g4 + 4 * hi) * 2) = w0; *(LAS u32x2*)(stg + r32 * 128 + 64 + (8 * g4 + 4 * hi) * 2) = w1;
              }
              asm volatile("s_waitcnt lgkmcnt(0)" ::: "memory");
              bf16_t* ow = Om + (size_t)(b * 2048 + 256 * qb + 32 * wave) * 1024 + h * 64;
#pragma unroll
              for (int i = 0; i < 4; ++i) { const int row = i * 8 + (lane >> 3), ch = lane & 7;
                *(u32x4*)(ow + (size_t)row * 1024 + ch * 8) = *(const LAS u32x4*)(stg + row * 128 + ch * 16); }
              asm volatile("s_waitcnt lgkmcnt(0)" ::: "memory");
            }
          }
#undef ATT_LOAD
#undef ATT_STORE
        }
      } break;
      case 13: g = pg8::Gemm{(const bf16_t*)(ws + OFF_OM), (const bf16_t*)(ws + OFF_WMOT), MTOK, 1024, 1024}; epi = EPI_YB; break;
      case 14: g = pg8::Gemm{(const bf16_t*)(ws + OFF_MIX), (const bf16_t*)(ws + OFF_WOUTT), MTOK, 1024, 1024}; epi = EPI_WOUT; break;
      case 15: norm_mod_rows(p.out, p.norm2_g, mod, 3072, 4096, (bf16_t*)(ws + OFF_HB2), gw, NGW, lane); break;
      case 16: g = pg8::Gemm{(const bf16_t*)(ws + OFF_HB2), (const bf16_t*)(ws + OFF_W1T), MTOK, 4096, 1024}; epi = EPI_W1; break;
      case 17: g = pg8::Gemm{(const bf16_t*)(ws + OFF_HID), (const bf16_t*)(ws + OFF_W2T), MTOK, 1024, 4096}; epi = EPI_W2; sync = false; break;
    }
    if (epi >= 0) {
      __syncthreads();
      pg8::StaticOrder S; S.init(g.M, g.N, G, bx);
      EpiSwitch E{epi, ws, p.x, p.out, p.b_merge, p.q_lat_g, p.kv_lat_g, (PROBE_PH == ph && probe_reps == 0) ? 1 : 0};
      int tid2 = threadIdx.x; asm volatile("" : "+v"(tid2));
      pg8::gemm_phase(lds, g, S, E, tid2);
      __syncthreads();
    }
    if (sync) { if (G == 0x7fffffff) grid.sync(); else xcd_barrier(xbar); }
#ifdef PROBE_SYNC
    if (sync) xcd_barrier(xbar);
#endif
    if (ph == PROBE_PH && probe_reps < 1) { ++probe_reps; --ph; }
  }
}

#undef p
extern "C" void kernel_launch(void* const* d_in, const int* in_sizes, int n_in, void* d_out, int out_size, void* d_ws, size_t ws_size, hipStream_t stream) {
  static int grid_blocks = 0;
  if (!grid_blocks) {
    int dev = 0, cus = 0, per_cu = 0;
    (void)hipGetDevice(&dev);
    (void)hipDeviceGetAttribute(&cus, hipDeviceAttributeMultiprocessorCount, dev);
    (void)hipFuncSetAttribute((const void*)fwd_kernel, hipFuncAttributeMaxDynamicSharedMemorySize, (int)LDS_BYTES);
    (void)hipOccupancyMaxActiveBlocksPerMultiprocessor(&per_cu, (const void*)fwd_kernel, 512, LDS_BYTES);
    if (per_cu < 1) per_cu = 1;
    if (per_cu > 1) per_cu = 1;
    grid_blocks = cus * per_cu;
    if (ws_size < WS_END || n_in != 23) { fprintf(stderr, "kernel_launch: unexpected ws_size %zu / n_in %d\n", ws_size, n_in); }
  }
  Params p{};
  p.x = (const float*)d_in[0]; p.c = (const float*)d_in[1]; p.pos = (const int*)d_in[2];
  p.w_ada = (const float*)d_in[3]; p.b_ada = (const float*)d_in[4]; p.norm1_g = (const float*)d_in[5]; p.w_in = (const float*)d_in[6]; p.b_merge = (const float*)d_in[7];
  p.w_alpha = (const float*)d_in[8]; p.b_alpha = (const float*)d_in[9]; p.gla_gn = (const float*)d_in[10]; p.gla_w_o = (const float*)d_in[11];
  p.q_lat_g = (const float*)d_in[12]; p.w_uq = (const float*)d_in[13]; p.kv_lat_g = (const float*)d_in[14]; p.w_ukv = (const float*)d_in[15];
  p.qn_g = (const float*)d_in[16]; p.kn_g = (const float*)d_in[17]; p.mla_w_o = (const float*)d_in[18]; p.w_out = (const float*)d_in[19];
  p.norm2_g = (const float*)d_in[20]; p.w1 = (const float*)d_in[21]; p.w2 = (const float*)d_in[22];
  p.out = (float*)d_out; p.ws = (unsigned char*)d_ws;
  (void)hipMemsetAsync((unsigned char*)d_ws + OFF_CTL, 0, 16384, stream);
  void* args[] = {&p};
  hipError_t e = hipLaunchCooperativeKernel((void*)fwd_kernel, dim3(grid_blocks), dim3(512), args, LDS_BYTES, stream);
  if (e != hipSuccess) fprintf(stderr, "cooperative launch failed: %s (grid %d)\n", hipGetErrorString(e), grid_blocks);
}
```

```cpp
#include <hip/hip_runtime.h>
#include <hip/hip_cooperative_groups.h>
#include <cstdio>
#include <cstdint>
namespace cg = cooperative_groups;

#define LAS __attribute__((address_space(3)))
#define GAS __attribute__((address_space(1)))
typedef unsigned short bf16_t;
typedef short bf16x8 __attribute__((ext_vector_type(8)));
typedef float f32x4 __attribute__((ext_vector_type(4)));
typedef float f32x2 __attribute__((ext_vector_type(2)));
typedef float f32x16 __attribute__((ext_vector_type(16)));
typedef unsigned u32x4 __attribute__((ext_vector_type(4)));
typedef unsigned u32x2 __attribute__((ext_vector_type(2)));
typedef __bf16 bf16x2_t __attribute__((ext_vector_type(2)));

#define DI __device__ __forceinline__
DI unsigned pk2(float lo, float hi) { f32x2 v = {lo, hi}; bf16x2_t b = __builtin_convertvector(v, bf16x2_t); return __builtin_bit_cast(unsigned, b); }
DI unsigned short f2bf(float f) { return (unsigned short)(pk2(f, 0.f) & 0xffffu); }
DI float bflo(unsigned w) { return __uint_as_float(w << 16); }
DI float bfhi(unsigned w) { return __uint_as_float(w & 0xffff0000u); }
DI void unpack8(u32x4 w, float* f) { f[0] = bflo(w.x); f[1] = bfhi(w.x); f[2] = bflo(w.y); f[3] = bfhi(w.y); f[4] = bflo(w.z); f[5] = bfhi(w.z); f[6] = bflo(w.w); f[7] = bfhi(w.w); }
DI u32x4 pack8(const float* f) { u32x4 w; w.x = pk2(f[0], f[1]); w.y = pk2(f[2], f[3]); w.z = pk2(f[4], f[5]); w.w = pk2(f[6], f[7]); return w; }
DI void st_bf8(bf16_t* p, f32x4 a, f32x4 b) { u32x4 w; w.x = pk2(a[0], a[1]); w.y = pk2(a[2], a[3]); w.z = pk2(b[0], b[1]); w.w = pk2(b[2], b[3]); *(u32x4*)p = w; }
template <int CTRL> DI float dpp_f(float x) { return __int_as_float(__builtin_amdgcn_mov_dpp(__float_as_int(x), CTRL, 0xf, 0xf, true)); }
DI float xor_add32(float x) { auto rr = __builtin_amdgcn_permlane32_swap(__float_as_uint(x), __float_as_uint(x), false, false); return __uint_as_float(rr[0]) + __uint_as_float(rr[1]); }
DI float xor_max32(float x) { auto rr = __builtin_amdgcn_permlane32_swap(__float_as_uint(x), __float_as_uint(x), false, false); return fmaxf(__uint_as_float(rr[0]), __uint_as_float(rr[1])); }
DI float xor_add16(float x) { auto rr = __builtin_amdgcn_permlane16_swap(__float_as_uint(x), __float_as_uint(x), false, false); return __uint_as_float(rr[0]) + __uint_as_float(rr[1]); }
DI float row16_sum(float v) { v += dpp_f<0xB1>(v); v += dpp_f<0x4E>(v); v += dpp_f<0x141>(v); v += dpp_f<0x140>(v); return v; }
DI float wave_sum(float v) { v = row16_sum(v); v = xor_add16(v); return xor_add32(v); }
DI float xor_max16(float x) { auto rr = __builtin_amdgcn_permlane16_swap(__float_as_uint(x), __float_as_uint(x), false, false); return fmaxf(__uint_as_float(rr[0]), __uint_as_float(rr[1])); }
DI float wave_max(float v) { v = fmaxf(v, dpp_f<0xB1>(v)); v = fmaxf(v, dpp_f<0x4E>(v)); v = fmaxf(v, dpp_f<0x141>(v)); v = fmaxf(v, dpp_f<0x140>(v)); v = xor_max16(v); return xor_max32(v); }
#define LDS_BARRIER() do { asm volatile("s_waitcnt lgkmcnt(0)" ::: "memory"); __builtin_amdgcn_s_barrier(); asm volatile("" ::: "memory"); } while (0)
DI float sigmoidf_(float x) { return __builtin_amdgcn_rcpf(1.0f + __expf(-x)); }
DI float rsq_(float x) { return __builtin_amdgcn_rsqf(x); }

constexpr int MTOK = 32768, DMODEL = 1024, SEQ = 2048, NBATCH = 16, DFF = 4096;
constexpr float EPS = 1e-6f;
constexpr int INW = 5552;
constexpr int C_GQ = 0, C_GK = 512, C_GV = 1024, C_GG = 2048, C_GA = 3072, C_CQ = 3088, C_CKV = 3344, C_KPE = 3472, C_MG = 3504;

constexpr size_t MB = 1u << 20;
constexpr size_t OFF_MOD = 0, OFF_COS = 1 * MB, OFF_SIN = 3 * MB, OFF_DECAY = 5 * MB, OFF_KPER = 6 * MB, OFF_KPESS = 8 * MB, OFF_KSS = 9 * MB,
                 OFF_KPE = 11 * MB, OFF_ALR = 15 * MB, OFF_CQSS = 17 * MB, OFF_CKVSS = 17 * MB + 256 * 1024, OFF_CTL = 17 * MB + 512 * 1024;
constexpr size_t OFF_WINN = 18 * MB, OFF_WINT = 26 * MB, OFF_WUQT = 29 * MB, OFF_WUKT = 30 * MB, OFF_WUVT = 30 * MB + 256 * 1024, OFF_WGOT = 31 * MB,
                 OFF_WMOT = 33 * MB, OFF_WOUTT = 35 * MB, OFF_W1T = 37 * MB, OFF_W2T = 45 * MB;
constexpr size_t SL1 = 54 * MB, SL2 = 118 * MB, SL3 = 182 * MB, SL4 = 246 * MB, SL5 = 310 * MB, SL6 = 374 * MB;
constexpr size_t OFF_GATEA = SL1, OFF_KNOPE = SL1, OFF_HB2 = SL1;
constexpr size_t OFF_GATEB = SL2, OFF_HID = SL2;
constexpr size_t OFF_GS = SL3, OFF_MIX = SL3;
constexpr size_t OFF_VT = SL4, OFF_VMT = SL4;
constexpr size_t OFF_HB = SL5, OFF_OG = SL5, OFF_OM = SL5;
constexpr size_t OFF_QG = SL6, OFF_KT = SL6 + 32 * MB, OFF_Q = SL6;
constexpr size_t OFF_CQN = 470 * MB, OFF_CKVN = 486 * MB;
constexpr size_t WS_END = 502 * MB;

struct Params {
  const float *x, *c; const int* pos;
  const float *w_ada, *b_ada, *norm1_g, *w_in, *b_merge, *w_alpha, *b_alpha, *gla_gn, *gla_w_o, *q_lat_g, *w_uq, *kv_lat_g, *w_ukv, *qn_g, *kn_g, *mla_w_o,
      *w_out, *norm2_g, *w1, *w2;
  float* out; unsigned char* ws;
};

namespace pg8 {
constexpr int BM = 256, BK = 64, HALF = 128, HTB = HALF * BK * 2, STAGE_BYTES = 8 * HTB, NXCD = 8, WGM = 8;
__host__ __device__ __forceinline__ int lds_byte(int r, int c) { const int st = (r >> 4) * 2 + (c >> 5), rr = r & 15, cc = c & 31, ob = rr * 64 + cc * 2; return st * 1024 + (ob ^ (((ob >> 9) & 1) << 5)); }
__host__ __device__ __forceinline__ void stage_rc(int b, int& R, int& C) { const int st = b / 1024, sb = b % 1024, swz = sb ^ (((sb >> 9) & 1) << 5); R = (st >> 1) * 16 + swz / 64; C = (st & 1) * 32 + (swz % 64) / 2; }
__host__ __device__ __forceinline__ int perm32(int rho) { const int n = rho >> 4, i = rho & 15; return 8 * (i >> 2) + 4 * n + (i & 3); }
struct Unit { int pm, pn; };
struct Gemm { const bf16_t* A; const bf16_t* Bt; int M, N, K; };
struct StaticOrder {
  int nM, nN, nwg, G, c;
  __device__ void init(int M, int N, int G_, int c_) { nM = M / BM; nN = N / BM; nwg = nM * nN; G = G_; c = c_; }
  __device__ bool next(int i, Unit& u) const {
    const long L = (long)i * G + c; if (L >= nwg) return false;
    int wgid = (int)L; { const int q = nwg / NXCD, r = nwg % NXCD, xcd = wgid % NXCD, off = wgid / NXCD; wgid = (xcd < r ? xcd * (q + 1) : r * (q + 1) + (xcd - r) * q) + off; }
    const int nig = WGM * nN, gid = wgid / nig, fm = gid * WGM, gsz = (nM - fm) < WGM ? (nM - fm) : WGM;
    u.pm = fm + ((wgid % nig) % gsz); u.pn = (wgid % nig) / gsz; return true;
  }
};
template <class Epi>
__device__ __forceinline__ void gemm_phase(LAS unsigned char* lds, const Gemm g, const StaticOrder& S, const Epi& E, const int tid) {
  const int wid = __builtin_amdgcn_readfirstlane(tid >> 6), lane = tid & 63, wr = wid >> 2, wc = wid & 3, fr = lane & 15, fq = lane >> 4;
  const int K = g.K, nt = K / BK;
  unsigned voffA[2], voffB[2];
#pragma unroll
  for (int i = 0; i < 2; ++i) { int R, C; stage_rc(tid * 16 + i * 8192, R, C); const int Rb = (R & ~31) + perm32(R & 31);
    voffA[i] = (unsigned)(R * K + C) * 2u; voffB[i] = (unsigned)(Rb * K + C) * 2u; }
  const size_t kstep = (size_t)(BK * 2);
  const size_t hstep = (size_t)HALF * K * 2;
  const size_t tstep = 2 * hstep;
  const unsigned ldsw = (unsigned)wid * 1024u;
  const int aoff = lds_byte(wr * 64 + fr, fq * 8), boff = lds_byte(wc * 32 + fr, fq * 8);
#define PG8_SA(b, h) (((b) * 2 + (h)) * HTB)
#define PG8_SB(b, h) ((4 + (b) * 2 + (h)) * HTB)
#define PG8_STAGE(bufoff, gbase, voff) do { _Pragma("unroll") for (int _i = 0; _i < 2; ++_i) \
    __builtin_amdgcn_global_load_lds((const unsigned*)((const char*)(gbase) + (voff)[_i]), (LAS unsigned*)(lds + (bufoff) + ldsw + _i * 8192), 16, 0, 0); } while (0)
#define PG8_LDA(dst, b, h) do { _Pragma("unroll") for (int m = 0; m < 4; ++m) _Pragma("unroll") for (int k = 0; k < 2; ++k) dst[m][k] = *(const LAS bf16x8*)(lds + PG8_SA(b, h) + aoff + m * 2048 + k * 1024); } while (0)
#define PG8_LDB(dst, b, h) do { _Pragma("unroll") for (int n = 0; n < 2; ++n) _Pragma("unroll") for (int k = 0; k < 2; ++k) dst[n][k] = *(const LAS bf16x8*)(lds + PG8_SB(b, h) + boff + n * 2048 + k * 1024); } while (0)
#define PG8_MMA(ai, bj, At, Bt) do { __builtin_amdgcn_s_setprio(1); _Pragma("unroll") for (int m = 0; m < 4; ++m) _Pragma("unroll") for (int n = 0; n < 2; ++n) _Pragma("unroll") for (int k = 0; k < 2; ++k) \
    acc[ai][bj][m][n] = __builtin_amdgcn_mfma_f32_16x16x32_bf16(Bt[n][k], At[m][k], acc[ai][bj][m][n], 0, 0, 0); __builtin_amdgcn_s_setprio(0); } while (0)
#define PG8_WAIT_V(n) asm volatile("s_waitcnt vmcnt(" #n ")" ::: "memory")
#define PG8_WAIT_L(n) asm volatile("s_waitcnt lgkmcnt(" #n ")" ::: "memory")
#define PG8_BAR __builtin_amdgcn_s_barrier()
#define PG8_SCHED __builtin_amdgcn_sched_barrier(0)
  Unit cur, nxt; int ui = 0;
  if (!S.next(0, cur)) return;
  f32x4 acc[2][2][4][2];
#pragma unroll
  for (int a = 0; a < 2; ++a)
#pragma unroll
    for (int b = 0; b < 2; ++b)
#pragma unroll
      for (int m = 0; m < 4; ++m)
#pragma unroll
        for (int n = 0; n < 2; ++n) acc[a][b][m][n] = (f32x4){0.f, 0.f, 0.f, 0.f};
  bf16x8 At[4][2], B0[2][2], B1[2][2];
  const char* cA = (const char*)g.A + (size_t)cur.pm * tstep; const char* cB = (const char*)g.Bt + (size_t)cur.pn * tstep;
  PG8_STAGE(PG8_SB(0, 0), cB, voffB); PG8_STAGE(PG8_SB(0, 1), cB + hstep, voffB); PG8_STAGE(PG8_SA(0, 0), cA, voffA); PG8_STAGE(PG8_SA(0, 1), cA + hstep, voffA);
  if (wr == 1) PG8_BAR;
  PG8_WAIT_V(2); PG8_BAR;
  PG8_STAGE(PG8_SB(1, 0), cB + kstep, voffB); PG8_STAGE(PG8_SA(1, 0), cA + kstep, voffA); PG8_STAGE(PG8_SB(1, 1), cB + hstep + kstep, voffB);
  PG8_WAIT_V(6); PG8_BAR;
  for (;;) {
    const bool has_next = S.next(ui + 1, nxt);
    const char* nA = has_next ? (const char*)g.A + (size_t)nxt.pm * tstep : cA; const char* nB = has_next ? (const char*)g.Bt + (size_t)nxt.pn * tstep : cB;
    for (int t = 0; t < nt; t += 2) {
      const bool last = (t == nt - 2);
      const char* a1 = cA + (size_t)(t + 1) * kstep;
      const char* a2 = last ? nA : cA + (size_t)(t + 2) * kstep; const char* b2 = last ? nB : cB + (size_t)(t + 2) * kstep;
      const char* a3 = a2 + kstep; const char* b3 = b2 + kstep;
      PG8_LDB(B0, 0, 0); PG8_LDB(B1, 0, 1); PG8_SCHED; PG8_LDA(At, 0, 0); PG8_STAGE(PG8_SA(1, 1), a1 + hstep, voffA);
      PG8_WAIT_V(8); PG8_WAIT_L(0); PG8_BAR; PG8_MMA(0, 0, At, B0); PG8_MMA(0, 1, At, B1); PG8_BAR; PG8_SCHED;
      PG8_LDA(At, 0, 1); PG8_STAGE(PG8_SB(0, 0), b2, voffB); PG8_STAGE(PG8_SB(0, 1), b2 + hstep, voffB); PG8_STAGE(PG8_SA(0, 0), a2, voffA);
      PG8_WAIT_V(8); PG8_WAIT_L(0); PG8_BAR; PG8_MMA(1, 0, At, B0); PG8_MMA(1, 1, At, B1); PG8_BAR; PG8_SCHED;
      PG8_LDB(B0, 1, 0); PG8_LDB(B1, 1, 1); PG8_SCHED; PG8_LDA(At, 1, 0); PG8_STAGE(PG8_SA(0, 1), a2 + hstep, voffA);
      PG8_WAIT_V(8); PG8_WAIT_L(0); PG8_BAR; PG8_MMA(0, 0, At, B0); PG8_MMA(0, 1, At, B1); PG8_BAR; PG8_SCHED;
      PG8_LDA(At, 1, 1); PG8_STAGE(PG8_SB(1, 0), b3, voffB); PG8_STAGE(PG8_SB(1, 1), b3 + hstep, voffB); PG8_STAGE(PG8_SA(1, 0), a3, voffA);
      PG8_WAIT_V(8); PG8_WAIT_L(0); PG8_BAR; PG8_MMA(1, 0, At, B0); PG8_MMA(1, 1, At, B1); PG8_BAR; PG8_SCHED;
    }
    if (wr == 0) PG8_BAR;
#pragma unroll
    for (int ai = 0; ai < 2; ++ai)
#pragma unroll
      for (int m = 0; m < 4; ++m) {
        const int row = cur.pm * BM + ai * HALF + wr * 64 + m * 16 + fr;
#pragma unroll
        for (int bj = 0; bj < 2; ++bj) E(row, cur.pn * BM + bj * HALF + wc * 32 + 8 * fq, acc[ai][bj][m][0], acc[ai][bj][m][1]);
      }
    if (!has_next) break;
#pragma unroll
    for (int a = 0; a < 2; ++a)
#pragma unroll
      for (int b = 0; b < 2; ++b)
#pragma unroll
        for (int m = 0; m < 4; ++m)
#pragma unroll
          for (int n = 0; n < 2; ++n) acc[a][b][m][n] = (f32x4){0.f, 0.f, 0.f, 0.f};
    cur = nxt; cA = nA; cB = nB; ++ui;
    if (wr == 1) PG8_BAR;
  }
  PG8_WAIT_V(0);
  PG8_BAR;
#undef PG8_SA
#undef PG8_SB
#undef PG8_STAGE
#undef PG8_LDA
#undef PG8_LDB
#undef PG8_MMA
#undef PG8_WAIT_V
#undef PG8_WAIT_L
#undef PG8_BAR
#undef PG8_SCHED
}
}

enum { EPI_PROJN = 0, EPI_PROJT, EPI_YA, EPI_QUP, EPI_KUP, EPI_VUPT, EPI_YB, EPI_WOUT, EPI_W1, EPI_W2 };
struct EpiSwitch {
  int id; unsigned char* ws; const float* x; float* out; const float* b_merge; const float* q_lat_g; const float* kv_lat_g; int dry;
  DI void operator()(int row, int col, f32x4 v0, f32x4 v1) const {
    switch (id) {
      case EPI_PROJN: {
        if (col < 512) { const float s = 0.08838834764831845f; st_bf8((bf16_t*)(ws + OFF_QG) + (size_t)row * 512 + col, v0 * s, v1 * s); }
        else if (col < 1536) {
#pragma unroll
          for (int i = 0; i < 4; ++i) { v0[i] = v0[i] * sigmoidf_(v0[i]); v1[i] = v1[i] * sigmoidf_(v1[i]); }
          st_bf8((bf16_t*)(ws + OFF_GS) + (size_t)row * 1024 + (col - 512), v0, v1);
        } else if (col < 3584) {
          const int c2 = col - 1536; const f32x4 b0 = *(const f32x4*)(b_merge + c2), b1 = *(const f32x4*)(b_merge + c2 + 4);
#pragma unroll
          for (int i = 0; i < 4; ++i) { v0[i] = sigmoidf_(v0[i] + b0[i]); v1[i] = sigmoidf_(v1[i] + b1[i]); }
          bf16_t* dst = (c2 < 1024) ? (bf16_t*)(ws + OFF_GATEA) + (size_t)row * 1024 + c2 : (bf16_t*)(ws + OFF_GATEB) + (size_t)row * 1024 + (c2 - 1024);
          st_bf8(dst, v0, v1);
        } else if (col < 3968) {
          const bool isq = col < 3840; const int c2 = isq ? col - 3584 : col - 3840; const float* gp = (isq ? q_lat_g : kv_lat_g) + c2;
          const f32x4 g0 = *(const f32x4*)gp, g1 = *(const f32x4*)(gp + 4);
          float ss = (v0[0] * v0[0] + v0[1] * v0[1]) + (v0[2] * v0[2] + v0[3] * v0[3]) + (v1[0] * v1[0] + v1[1] * v1[1]) + (v1[2] * v1[2] + v1[3] * v1[3]);
          ss = xor_add16(ss); ss = xor_add32(ss);
          bf16_t* dst = isq ? (bf16_t*)(ws + OFF_CQN) + (size_t)row * 256 + c2 : (bf16_t*)(ws + OFF_CKVN) + (size_t)row * 128 + c2;
          st_bf8(dst, v0 * g0, v1 * g1);
          if ((threadIdx.x & 48) == 0) atomicAdd((float*)(ws + (isq ? OFF_CQSS : OFF_CKVSS)) + row, ss);
        }
        else if (col < 4000) { float* d = (float*)(ws + OFF_KPE) + (size_t)row * 32 + (col - 3968); *(f32x4*)d = v0; *(f32x4*)(d + 4) = v1; }
        else if (col < 4016) { float* d = (float*)(ws + OFF_ALR) + (size_t)row * 16 + (col - 4000); *(f32x4*)d = v0; *(f32x4*)(d + 4) = v1; }
      } break;
      case EPI_PROJT: {
        bf16_t* dst = (row < 512) ? (bf16_t*)(ws + OFF_KT) + ((size_t)(col >> 6) * 512 + row) * 64 + (col & 63) : (bf16_t*)(ws + OFF_VT) + ((size_t)(col >> 6) * 1024 + (row - 512)) * 64 + (col & 63);
        st_bf8(dst, v0, v1);
      } break;
      case EPI_YA: {
        const u32x4 gw = *(const u32x4*)((const bf16_t*)(ws + OFF_GATEA) + (size_t)row * 1024 + col); float g[8]; unpack8(gw, g);
#pragma unroll
        for (int i = 0; i < 4; ++i) { v0[i] *= g[i]; v1[i] *= g[4 + i]; }
        st_bf8((bf16_t*)(ws + OFF_MIX) + (size_t)row * 1024 + col, v0, v1);
      } break;
      case EPI_QUP: { const float al = rsq_(((const float*)(ws + OFF_CQSS))[row] * (1.0f / 256.0f) + EPS);
        st_bf8((bf16_t*)(ws + OFF_Q) + (size_t)row * 1536 + col, v0 * al, v1 * al); } break;
      case EPI_KUP: { const float al = rsq_(((const float*)(ws + OFF_CKVSS))[row] * (1.0f / 128.0f) + EPS);
        v0 = v0 * al; v1 = v1 * al;
        float ss = (v0[0] * v0[0] + v0[1] * v0[1]) + (v0[2] * v0[2] + v0[3] * v0[3]) + (v1[0] * v1[0] + v1[1] * v1[1]) + (v1[2] * v1[2] + v1[3] * v1[3]);
        ss = xor_add16(ss); ss = xor_add32(ss);
        st_bf8((bf16_t*)(ws + OFF_KNOPE) + ((size_t)((row >> 11) * 16 + (col >> 6)) * 2048 + (row & 2047)) * 64 + (col & 63), v0, v1);
        if ((threadIdx.x & 48) == 0) atomicAdd((float*)(ws + OFF_KSS) + (size_t)row * 16 + (col >> 6), ss); } break;
      case EPI_VUPT: { const float* cs = (const float*)(ws + OFF_CKVSS) + col; const f32x4 c0 = *(const f32x4*)cs, c1 = *(const f32x4*)(cs + 4);
#pragma unroll
        for (int i = 0; i < 4; ++i) { v0[i] *= rsq_(c0[i] * (1.0f / 128.0f) + EPS); v1[i] *= rsq_(c1[i] * (1.0f / 128.0f) + EPS); }
        st_bf8((bf16_t*)(ws + OFF_VMT) + ((size_t)(col >> 6) * 1024 + row) * 64 + (col & 63), v0, v1); } break;
      case EPI_YB: {
        const u32x4 gw = *(const u32x4*)((const bf16_t*)(ws + OFF_GATEB) + (size_t)row * 1024 + col); float g[8]; unpack8(gw, g);
        bf16_t* mp = (bf16_t*)(ws + OFF_MIX) + (size_t)row * 1024 + col; const u32x4 tw = *(const u32x4*)mp; float t[8]; unpack8(tw, t);
#pragma unroll
        for (int i = 0; i < 4; ++i) { v0[i] = t[i] + v0[i] * g[i]; v1[i] = t[4 + i] + v1[i] * g[4 + i]; }
        st_bf8(dry ? (bf16_t*)(ws + SL4) + (size_t)row * 1024 + col : mp, v0, v1);
      } break;
      case EPI_WOUT: {
        const float* mod = (const float*)(ws + OFF_MOD) + (size_t)(row >> 11) * 6144 + 2048 + col;
        const f32x4 g0 = *(const f32x4*)mod, g1 = *(const f32x4*)(mod + 4);
        const float* xp = x + (size_t)row * 1024 + col; const f32x4 x0 = __builtin_nontemporal_load((const f32x4*)xp), x1 = __builtin_nontemporal_load((const f32x4*)(xp + 4));
        float* op = out + (size_t)row * 1024 + col; *(f32x4*)op = x0 + g0 * v0; *(f32x4*)(op + 4) = x1 + g1 * v1;
      } break;
      case EPI_W1: {
#pragma unroll
        for (int i = 0; i < 4; ++i) { const float a = fmaxf(v0[i], 0.f), b = fmaxf(v1[i], 0.f); v0[i] = a * a; v1[i] = b * b; }
        st_bf8((bf16_t*)(ws + OFF_HID) + (size_t)row * 4096 + col, v0, v1);
      } break;
      case EPI_W2: {
        const float* mod = (const float*)(ws + OFF_MOD) + (size_t)(row >> 11) * 6144 + 5120 + col;
        const f32x4 g0 = *(const f32x4*)mod, g1 = *(const f32x4*)(mod + 4);
        float* op = out + (size_t)row * 1024 + col; const f32x4 x0 = *(const f32x4*)op, x1 = *(const f32x4*)(op + 4);
        if (dry) op = (float*)(ws + SL6) + (size_t)row * 1024 + col;
        __builtin_nontemporal_store(x0 + g0 * v0, (f32x4*)op); __builtin_nontemporal_store(x1 + g1 * v1, (f32x4*)(op + 4));
      } break;
    }
  }
};

DI void tr_item(const float* __restrict__ src, int ld, int col0, int gs, int nvalid, int nrows, int K, bf16_t* dst, LAS float* scr, int item, int lane, bool sw23 = false) {
  const int nblk = nrows / 32, kb = item / nblk, nb = item % nblk, k0 = 64 * kb, n0 = 32 * nb;
  const int n = n0 + (lane & 31); const int ns = sw23 ? ((n & ~12) | ((n & 4) << 1) | ((n & 8) >> 1)) : n; const int scol = col0 + (ns >> 6) * gs + (ns & 63); const bool ok = n < nvalid;
#pragma unroll
  for (int i = 0; i < 32; ++i) { const int kk = 2 * i + (lane >> 5); scr[kk * 33 + (lane & 31)] = ok ? __builtin_nontemporal_load(&src[(size_t)(k0 + kk) * ld + scol]) : 0.f; }
  asm volatile("s_waitcnt lgkmcnt(0)" ::: "memory");
  const int c = lane & 7;
#pragma unroll
  for (int j = 0; j < 4; ++j) { const int nn = (lane >> 3) + 8 * j; const LAS float* s = scr + (8 * c) * 33 + nn;
    u32x4 o; o.x = pk2(s[0 * 33], s[1 * 33]); o.y = pk2(s[2 * 33], s[3 * 33]); o.z = pk2(s[4 * 33], s[5 * 33]); o.w = pk2(s[6 * 33], s[7 * 33]);
    *(u32x4*)(dst + (size_t)(n0 + nn) * K + k0 + 8 * c) = o; }
  asm volatile("s_waitcnt lgkmcnt(0)" ::: "memory");
}

DI void norm_mod_rows(const float* __restrict__ X, const float* __restrict__ g, const float* __restrict__ mod, int shift_off, int scale_off, bf16_t* __restrict__ H, int gw, int NGW, int lane) {
  for (int m = gw; m < MTOK; m += 2 * NGW) {
    f32x4 v[2][4]; float s[2];
#pragma unroll
    for (int r = 0; r < 2; ++r) { const int mr = (m + r * NGW < MTOK) ? m + r * NGW : m; const f32x4* xr = (const f32x4*)(X + (size_t)mr * 1024) + lane;
#pragma unroll
      for (int j = 0; j < 4; ++j) v[r][j] = __builtin_nontemporal_load(&xr[64 * j]); }
#pragma unroll
    for (int r = 0; r < 2; ++r) { float a = 0.f;
#pragma unroll
      for (int j = 0; j < 4; ++j) a += (v[r][j][0] * v[r][j][0] + v[r][j][1] * v[r][j][1]) + (v[r][j][2] * v[r][j][2] + v[r][j][3] * v[r][j][3]);
      s[r] = a; }
    s[0] = wave_sum(s[0]); s[1] = wave_sum(s[1]);
#pragma unroll
    for (int r = 0; r < 2; ++r) {
      const int mm = (m + r * NGW < MTOK) ? m + r * NGW : m, b = mm >> 11; const float rinv = rsq_(s[r] * (1.0f / 1024.0f) + EPS);
#pragma unroll
      for (int j = 0; j < 4; ++j) { const int col = 4 * lane + 256 * j;
        const f32x4 g4 = *(const f32x4*)(g + col), sc = *(const f32x4*)(mod + b * 6144 + scale_off + col), sh = *(const f32x4*)(mod + b * 6144 + shift_off + col);
        f32x4 o = v[r][j] * rinv * g4 * (sc + 1.0f) + sh;
        u32x2 w; w.x = pk2(o[0], o[1]); w.y = pk2(o[2], o[3]); *(u32x2*)(H + (size_t)mm * 1024 + col) = w; }
    }
  }
}

#define XB_TMO      128
#define XB_XCNT(j)  (256  + 64 * (j))
#define XB_XSUB(j)  (1280 + 64 * (j))
#define XB_XGEN(j)  (2304 + 64 * (j))
#define XB_TOP      3328
#define XB_TOPGEN   3392
#define XCD_BAR_WORDS 3456
#define XB_SPIN_CAP (1u << 18)
DI unsigned xb_ld(unsigned* p) { return __hip_atomic_load(p, __ATOMIC_RELAXED, __HIP_MEMORY_SCOPE_AGENT); }
DI unsigned xb_add(unsigned* p, unsigned v) { return __hip_atomic_fetch_add(p, v, __ATOMIC_RELAXED, __HIP_MEMORY_SCOPE_AGENT); }
DI unsigned xb_xcc_id() { return (unsigned)__builtin_amdgcn_s_getreg((3 << 11) | 20) & 0xFu; }
#define XB_SPIN(cond, bar) do { unsigned _sp = 0; while (cond) { __builtin_amdgcn_s_sleep(1); \
    if ((++_sp & 255u) == 0u) { if (xb_ld(&(bar)[XB_TMO])) break; if (_sp > XB_SPIN_CAP) { atomicAdd(&(bar)[XB_TMO], 1u); break; } } } } while (0)
struct XcdBarrier { unsigned* bar; unsigned x; volatile LAS unsigned* st; };
DI XcdBarrier xcd_barrier_post(unsigned* bar, volatile LAS unsigned* st) {
  XcdBarrier b; b.bar = bar; b.x = xb_xcc_id(); b.st = st;
  if (threadIdx.x == 0) (void)xb_add(&bar[XB_XCNT(b.x)], 1u);
  return b;
}
DI void xcd_barrier_complete(unsigned* bar, unsigned x, unsigned& nloc, unsigned& nx) {
  const unsigned G = gridDim.x * gridDim.y * gridDim.z;
  unsigned sum, cnt, mine, sp = 0u;
  for (;;) {
    sum = 0u; cnt = 0u; mine = 0u;
#pragma unroll
    for (unsigned j = 0; j < 16; ++j) { const unsigned c = xb_ld(&bar[XB_XCNT(j)]); sum += c; cnt += (c > 0u) ? 1u : 0u; mine = (j == x) ? c : mine; }
    if (sum == G) break;
    __builtin_amdgcn_s_sleep(1);
    if ((++sp & 255u) == 0u) { if (xb_ld(&bar[XB_TMO])) break; if (sp > XB_SPIN_CAP) { atomicAdd(&bar[XB_TMO], 1u); break; } }
  }
  nloc = mine > 0u ? mine : 1u; nx = cnt > 0u ? cnt : 1u;
}
DI void xcd_barrier(const XcdBarrier& b) {
  asm volatile("s_waitcnt vmcnt(0)" ::: "memory");
  __syncthreads();
  if (threadIdx.x == 0) {
    unsigned* bar = b.bar;
    __builtin_amdgcn_s_waitcnt(0);
    unsigned nloc = b.st[0], nx = b.st[1];
    if (nloc == 0u) { xcd_barrier_complete(bar, b.x, nloc, nx); b.st[0] = nloc; b.st[1] = nx; }
    const unsigned old = xb_add(&bar[XB_XSUB(b.x)], 1u);
    const unsigned gen = old / nloc;
    if (old + 1u == (gen + 1u) * nloc) {
      __builtin_amdgcn_fence(__ATOMIC_RELEASE, "agent");
      asm volatile("s_waitcnt vmcnt(0)" ::: "memory");
      const unsigned og = xb_add(&bar[XB_TOP], 1u);
      const unsigned tg = og / nx;
      if (og + 1u == (tg + 1u) * nx) xb_add(&bar[XB_TOPGEN], 1u);
      else XB_SPIN(xb_ld(&bar[XB_TOPGEN]) == tg, bar);
      __builtin_amdgcn_fence(__ATOMIC_ACQUIRE, "agent");
      xb_add(&bar[XB_XGEN(b.x)], 1u);
      asm volatile("s_waitcnt vmcnt(0)" ::: "memory");
    } else {
      XB_SPIN(xb_ld(&bar[XB_XGEN(b.x)]) == gen, bar);
      __builtin_amdgcn_fence(__ATOMIC_ACQUIRE, "agent");
      asm volatile("s_waitcnt vmcnt(0)" ::: "memory");
    }
  }
  __syncthreads();
}

constexpr int NPH = 18;
#ifndef PROBE_PH
#define PROBE_PH -1
#endif
constexpr size_t LDS_BYTES = 151552;

__global__ void __launch_bounds__(512, 2) fwd_kernel(Params p_in) {
  extern __shared__ __attribute__((aligned(16))) unsigned char lds_raw[];
  LAS unsigned char* lds = (LAS unsigned char*)lds_raw;
  cg::grid_group grid = cg::this_grid();
  volatile LAS unsigned* bar_st = (volatile LAS unsigned*)(lds + 151040);
  if (threadIdx.x < 2) bar_st[threadIdx.x] = 0u;
  __syncthreads();
  const XcdBarrier xbar = xcd_barrier_post((unsigned*)(p_in.ws + OFF_CTL), bar_st);
  int probe_reps = 0;
  for (int ph = 0; ph < NPH; ++ph) {
    int tid = threadIdx.x; asm volatile("" : "+v"(tid));
    int bx = blockIdx.x; asm volatile("" : "+s"(bx));
    int G = gridDim.x; asm volatile("" : "+s"(G));
    const __attribute__((address_space(4))) Params* kp = (const __attribute__((address_space(4))) Params*)__builtin_amdgcn_kernarg_segment_ptr(); asm volatile("" : "+s"(kp));
#define p (*kp)
    GAS unsigned char* wsg = (GAS unsigned char*)p.ws; asm volatile("" : "+s"(wsg)); unsigned char* ws = (unsigned char*)wsg;
    const int lane = tid & 63, wave = __builtin_amdgcn_readfirstlane(tid >> 6);
    const int gw = bx * 8 + wave, NGW = G * 8;
    float* mod = (float*)(ws + OFF_MOD);
    float* cosT = (float*)(ws + OFF_COS); float* sinT = (float*)(ws + OFF_SIN);
    pg8::Gemm g{nullptr, nullptr, 0, 0, 0}; int epi = -1; bool sync = true;
    switch (ph) {
      case 0: {
        LAS float* lf = (LAS float*)lds;
        LAS float* scr = lf + wave * (64 * 33);
        LAS float* sc = lf + 16896;
        if (bx < 192) {
#pragma unroll 8
          for (int idx = tid; idx < 16384; idx += 512) { const int b = idx >> 10, k = idx & 1023; const float cv = p.c[idx]; sc[k * 16 + b] = cv * __builtin_amdgcn_rcpf(1.0f + __expf(-cv)); } }
        bf16_t* WinN = (bf16_t*)(ws + OFF_WINN); bf16_t* WinT = (bf16_t*)(ws + OFF_WINT);
        constexpr int I1 = 256, I2 = 512, I3 = 1024, I4 = 128, I5 = 64, I6 = 16, I7 = 48, I8 = 256, I9 = 512, I10 = 192, I11 = 64, I12 = 64, I13 = 512, I14 = 512, I15 = 512, I16 = 2048, I17 = 2048;
        constexpr int NIT = I1 + I2 + I3 + I4 + I5 + I6 + I7 + I8 + I9 + I10 + I11 + I12 + I13 + I14 + I15 + I16 + I17;
        for (int it = gw; it < NIT; it += NGW) {
          int r = it;
          if (r < I1) { tr_item(p.w_in, INW, C_GQ, 64, 512, 512, 1024, WinN, scr, r, lane, true); continue; } r -= I1;
          if (r < I2) { tr_item(p.w_in, INW, C_GG, 64, 1024, 1024, 1024, WinN + (size_t)512 * 1024, scr, r, lane); continue; } r -= I2;
          if (r < I3) { tr_item(p.w_in, INW, C_MG, 64, 2048, 2048, 1024, WinN + (size_t)1536 * 1024, scr, r, lane); continue; } r -= I3;
          if (r < I4) { tr_item(p.w_in, INW, C_CQ, 64, 256, 256, 1024, WinN + (size_t)3584 * 1024, scr, r, lane); continue; } r -= I4;
          if (r < I5) { tr_item(p.w_in, INW, C_CKV, 64, 128, 128, 1024, WinN + (size_t)3840 * 1024, scr, r, lane); continue; } r -= I5;
          if (r < I6) { tr_item(p.w_in, INW, C_KPE, 64, 32, 32, 1024, WinN + (size_t)3968 * 1024, scr, r, lane); continue; } r -= I6;
          if (r < I7) { tr_item(p.w_in, INW, C_GA, 64, 16, 96, 1024, WinN + (size_t)4000 * 1024, scr, r, lane); continue; } r -= I7;
          if (r < I8) { tr_item(p.w_in, INW, C_GK, 64, 512, 512, 1024, WinT, scr, r, lane); continue; } r -= I8;
          if (r < I9) { tr_item(p.w_in, INW, C_GV, 64, 1024, 1024, 1024, WinT + (size_t)512 * 1024, scr, r, lane); continue; } r -= I9;
          if (r < I10) { tr_item(p.w_uq, 1536, 0, 64, 1536, 1536, 256, (bf16_t*)(ws + OFF_WUQT), scr, r, lane); continue; } r -= I10;
          if (r < I11) { tr_item(p.w_ukv, 2048, 0, 128, 1024, 1024, 128, (bf16_t*)(ws + OFF_WUKT), scr, r, lane); continue; } r -= I11;
          if (r < I12) { tr_item(p.w_ukv, 2048, 64, 128, 1024, 1024, 128, (bf16_t*)(ws + OFF_WUVT), scr, r, lane); continue; } r -= I12;
          if (r < I13) { tr_item(p.gla_w_o, 1024, 0, 64, 1024, 1024, 1024, (bf16_t*)(ws + OFF_WGOT), scr, r, lane); continue; } r -= I13;
          if (r < I14) { tr_item(p.mla_w_o, 1024, 0, 64, 1024, 1024, 1024, (bf16_t*)(ws + OFF_WMOT), scr, r, lane); continue; } r -= I14;
          if (r < I15) { tr_item(p.w_out, 1024, 0, 64, 1024, 1024, 1024, (bf16_t*)(ws + OFF_WOUTT), scr, r, lane); continue; } r -= I15;
          if (r < I16) { tr_item(p.w1, 4096, 0, 64, 4096, 4096, 1024, (bf16_t*)(ws + OFF_W1T), scr, r, lane); continue; } r -= I16;
          tr_item(p.w2, 1024, 0, 64, 1024, 1024, 4096, (bf16_t*)(ws + OFF_W2T), scr, r, lane);
        }
        for (int idx = bx * 512 + tid; idx < MTOK * 16; idx += G * 512) ((float*)(ws + OFF_KSS))[idx] = 0.f;
        for (int idx = bx * 512 + tid; idx < MTOK; idx += G * 512) { ((float*)(ws + OFF_CQSS))[idx] = 0.f; ((float*)(ws + OFF_CKVSS))[idx] = 0.f; }
#pragma unroll 4
        for (int idx = bx * 512 + tid; idx < MTOK * 16; idx += G * 512) {
          const int m = idx >> 4, i = idx & 15;
          const float freq = exp2f(-(float)i * 0.83048202372184058f);
          const float ang = (float)p.pos[m] * freq;
          double rev = (double)ang * 0.15915494309189535; rev -= rint(rev);
          const float fr = (float)rev;
          cosT[idx] = __builtin_amdgcn_cosf(fr); sinT[idx] = __builtin_amdgcn_sinf(fr);
        }
        __syncthreads();
        for (int u = bx; u < 192; u += G) {
          const int col = u * 32 + (lane & 31), k0 = wave * 128 + (lane >> 5);
          float acc[16];
#pragma unroll
          for (int b = 0; b < 16; ++b) acc[b] = 0.f;
#pragma unroll 16
          for (int i = 0; i < 64; ++i) {
            const int k = k0 + 2 * i;
            const float w = __builtin_nontemporal_load(&p.w_ada[(size_t)k * 6144 + col]);
            const LAS f32x4* s4 = (const LAS f32x4*)(sc + k * 16);
#pragma unroll
            for (int q = 0; q < 4; ++q) { const f32x4 sv4 = s4[q]; acc[4 * q] += sv4[0] * w; acc[4 * q + 1] += sv4[1] * w; acc[4 * q + 2] += sv4[2] * w; acc[4 * q + 3] += sv4[3] * w; }
          }
          LAS float* red = lf;
#pragma unroll
          for (int b = 0; b < 16; ++b) { const float t = xor_add32(acc[b]); if (lane < 32) red[(wave * 16 + b) * 32 + lane] = t; }
          __syncthreads();
          { const int o = tid; const int b = o >> 5, l = o & 31; float sum = p.b_ada[u * 32 + l];
#pragma unroll
            for (int w = 0; w < 8; ++w) sum += red[(w * 16 + b) * 32 + l];
            mod[b * 6144 + u * 32 + l] = sum; }
          __syncthreads();
        }
      } break;
      case 1: norm_mod_rows(p.x, p.norm1_g, mod, 0, 1024, (bf16_t*)(ws + OFF_HB), gw, NGW, lane); break;
      case 2: g = pg8::Gemm{(const bf16_t*)(ws + OFF_HB), (const bf16_t*)(ws + OFF_WINN), MTOK, 4096, 1024}; epi = EPI_PROJN; sync = false; break;
      case 3: g = pg8::Gemm{(const bf16_t*)(ws + OFF_WINT), (const bf16_t*)(ws + OFF_HB), 1536, MTOK, 1024}; epi = EPI_PROJT; break;
      case 4: {
        const float* KPE = (const float*)(ws + OFF_KPE); bf16_t* KpeR = (bf16_t*)(ws + OFF_KPER); float* KpeSS = (float*)(ws + OFF_KPESS);
        for (int idx = bx * 512 + tid; idx < MTOK * 16; idx += G * 512) {
          const int m = idx >> 4, i = idx & 15;
          const float x1 = KPE[(size_t)m * 32 + i], x2 = KPE[(size_t)m * 32 + 16 + i];
          const float y1 = x1 * p.kn_g[64 + i], y2 = x2 * p.kn_g[80 + i]; const float c = cosT[idx], sn = sinT[idx];
          KpeR[(size_t)m * 32 + i] = f2bf(y1 * c - y2 * sn); KpeR[(size_t)m * 32 + 16 + i] = f2bf(y2 * c + y1 * sn);
          float ss = row16_sum(x1 * x1 + x2 * x2);
          if (i == 0) KpeSS[m] = ss;
        }
        bf16_t* KT = (bf16_t*)(ws + OFF_KT); const float* ALR = (const float*)(ws + OFF_ALR); float* Decay = (float*)(ws + OFF_DECAY);
        for (int c = bx; c < 512; c += G) {
          const int m0 = c * 64, pc = tid & 7, fl = tid >> 3;
          f32x4 alr[8][4];
#pragma unroll
          for (int j = 0; j < 8; ++j)
#pragma unroll
            for (int q = 0; q < 4; ++q) alr[j][q] = *(const f32x4*)(ALR + (size_t)(m0 + 8 * pc + j) * 16 + 4 * q);
          for (int rb = 0; rb < 8; ++rb) {
            const int f = rb * 64 + fl;
            float w[16];
#pragma unroll
            for (int r = 0; r < 16; ++r) w[r] = p.w_alpha[r * 512 + f];
            const float ba = p.b_alpha[f];
            u32x4* kp = (u32x4*)(KT + ((size_t)c * 512 + f) * 64 + 8 * pc);
            float kv[8]; unpack8(*kp, kv);
            float la[8]; float tot = 0.f;
#pragma unroll
            for (int j = 0; j < 8; ++j) { float z = ba;
#pragma unroll
              for (int q = 0; q < 4; ++q) z += alr[j][q][0] * w[4 * q] + alr[j][q][1] * w[4 * q + 1] + alr[j][q][2] * w[4 * q + 2] + alr[j][q][3] * w[4 * q + 3];
              la[j] = (fminf(z, 0.f) - __logf(1.0f + __expf(-fabsf(z)))) * (1.0f / 16.0f); tot += la[j]; }
            float sfx = tot;
            { float t1 = __int_as_float(__builtin_amdgcn_ds_bpermute(((lane + 1) & 63) << 2, __float_as_int(sfx))); if (pc + 1 < 8) sfx += t1;
              float t2 = __int_as_float(__builtin_amdgcn_ds_bpermute(((lane + 2) & 63) << 2, __float_as_int(sfx))); if (pc + 2 < 8) sfx += t2;
              float t4 = __int_as_float(__builtin_amdgcn_ds_bpermute(((lane + 4) & 63) << 2, __float_as_int(sfx))); if (pc + 4 < 8) sfx += t4; }
            float rev = sfx - tot;
#pragma unroll
            for (int j = 7; j >= 0; --j) { kv[j] *= __expf(rev); rev += la[j]; }
            if (PROBE_PH == 4 && probe_reps == 0) *(u32x4*)((bf16_t*)(ws + SL5) + ((size_t)c * 512 + f) * 64 + 8 * pc) = pack8(kv); else *kp = pack8(kv);
            if (pc == 0) Decay[c * 512 + f] = __expf(rev);
          }
        }
      } break;
      case 5: {
        const bf16_t* KdT = (const bf16_t*)(ws + OFF_KT); const bf16_t* VT = (const bf16_t*)(ws + OFF_VT); const float* Decay = (const float*)(ws + OFF_DECAY);
        float* SL = (float*)(ws + 438 * MB);
        constexpr int A_KO = 0, A_DO = 18432, A_BF = 18944;
        const int r32 = lane & 31, hi = lane >> 5;
        for (int u = bx; u < 256; u += G) {
          const int bhu = u >> 2, seg = u & 3, b = bhu >> 2, h = bhu & 3, n0 = 8 * seg, nend = n0 + 8;
          if (seg == 3) continue;
          f32x16 S[4];
#pragma unroll
          for (int kb = 0; kb < 4; ++kb)
#pragma unroll
            for (int r = 0; r < 16; ++r) S[kb][r] = 0.f;
          u32x4 stK[2]; float sd = 0.f, dprod = 1.f; bf16x8 vcur[4], vnext[4];
          const bf16_t* vrow = VT + ((size_t)(b * 32) * 1024 + h * 256 + 32 * wave + r32) * 64 + 8 * hi;
#define GA_LOAD(n_) do { \
            _Pragma("unroll") for (int i = 0; i < 2; ++i) { const int id = tid + 512 * i; stK[i] = *(const u32x4*)(KdT + ((size_t)(b * 32 + (n_)) * 512 + h * 128 + (id >> 3)) * 64 + (id & 7) * 8); } \
            if (tid < 128) sd = Decay[(b * 32 + (n_)) * 512 + h * 128 + tid]; \
            _Pragma("unroll") for (int ts = 0; ts < 4; ++ts) vnext[ts] = *(const bf16x8*)(vrow + (size_t)(n_) * 65536 + 16 * ts); } while (0)
#define GA_STORE(buf_) do { LAS unsigned char* bs_ = lds + (buf_) * A_BF; \
            _Pragma("unroll") for (int i = 0; i < 2; ++i) { const int id = tid + 512 * i; *(LAS u32x4*)(bs_ + A_KO + (id >> 3) * 144 + (id & 7) * 16) = stK[i]; } \
            if (tid < 128) { *(LAS float*)(bs_ + A_DO + tid * 4) = sd; dprod *= sd; } } while (0)
          LDS_BARRIER();
          GA_LOAD(n0); GA_STORE(0);
#pragma unroll
          for (int ts = 0; ts < 4; ++ts) vcur[ts] = vnext[ts];
          GA_LOAD(n0 + 1);
          LDS_BARRIER();
          for (int n = n0; n < nend; ++n) {
            const LAS unsigned char* base = lds + (n & 1) * A_BF;
#pragma unroll
            for (int kb = 0; kb < 4; ++kb)
#pragma unroll
              for (int g4 = 0; g4 < 4; ++g4) { const f32x4 d4 = *(const LAS f32x4*)(base + A_DO + (32 * kb + 8 * g4 + 4 * hi) * 4);
#pragma unroll
                for (int j = 0; j < 4; ++j) S[kb][4 * g4 + j] *= d4[j]; }
#pragma unroll
            for (int ts = 0; ts < 4; ++ts)
#pragma unroll
              for (int kb = 0; kb < 4; ++kb) { const bf16x8 afr = *(const LAS bf16x8*)(base + A_KO + (32 * kb + r32) * 144 + (16 * ts + 8 * hi) * 2);
                S[kb] = __builtin_amdgcn_mfma_f32_32x32x16_bf16(afr, vcur[ts], S[kb], 0, 0, 0); }
            if (n + 1 < nend) GA_STORE((n + 1) & 1);
#pragma unroll
            for (int ts = 0; ts < 4; ++ts) vcur[ts] = vnext[ts];
            if (n + 2 < nend) GA_LOAD(n + 2);
            LDS_BARRIER();
          }
          f32x4* slp = (f32x4*)(SL + ((size_t)((bhu * 3 + seg) * 8 + wave) * 64 + lane) * 64);
#pragma unroll
          for (int kb = 0; kb < 4; ++kb)
#pragma unroll
            for (int g4 = 0; g4 < 4; ++g4) slp[kb * 4 + g4] = (f32x4){S[kb][4 * g4], S[kb][4 * g4 + 1], S[kb][4 * g4 + 2], S[kb][4 * g4 + 3]};
          if (tid < 128) ((float*)(ws + 462 * MB))[(bhu * 3 + seg) * 128 + tid] = dprod;
#undef GA_LOAD
#undef GA_STORE
        }
      } break;
      case 6: {
        const bf16_t* KdT = (const bf16_t*)(ws + OFF_KT); const bf16_t* VT = (const bf16_t*)(ws + OFF_VT); const bf16_t* Qg = (const bf16_t*)(ws + OFF_QG);
        const float* Decay = (const float*)(ws + OFF_DECAY); const bf16_t* Gs = (const bf16_t*)(ws + OFF_GS); bf16_t* Og = (bf16_t*)(ws + OFF_OG);
        constexpr int G_KOFF = 0, G_QOFF = 18432, G_DOFF = 35840, G_BUF = 36352, G_SS = 72704, G_OT = 76800;
        const int r32 = lane & 31, hi = lane >> 5;
        const float* SL = (const float*)(ws + 438 * MB);
        for (int u = bx; u < 256; u += G) {
          const int bhu = u >> 2, seg = u & 3, b = bhu >> 2, h = bhu & 3, n0 = 8 * seg, nend = n0 + 8;
          int tid_u = tid; asm volatile("" : "+v"(tid_u));
          const int tid = tid_u, lane = tid & 63, r32 = lane & 31, hi = lane >> 5;
          f32x16 S[4];
#pragma unroll
          for (int kb = 0; kb < 4; ++kb)
#pragma unroll
            for (int r = 0; r < 16; ++r) S[kb][r] = 0.f;
          for (int jp = 0; jp < seg; ++jp) {
            const f32x4* slp = (const f32x4*)(SL + ((size_t)((bhu * 3 + jp) * 8 + wave) * 64 + lane) * 64);
#pragma unroll
            for (int kb = 0; kb < 4; ++kb) {
              f32x4 d[4];
              const float* dp = (const float*)(ws + 462 * MB) + (bhu * 3 + jp) * 128 + 32 * kb + 4 * hi;
#pragma unroll
              for (int g4 = 0; g4 < 4; ++g4) d[g4] = *(const f32x4*)(dp + 8 * g4);
#pragma unroll
              for (int g4 = 0; g4 < 4; ++g4) { const f32x4 sl4 = slp[kb * 4 + g4];
#pragma unroll
                for (int j = 0; j < 4; ++j) S[kb][4 * g4 + j] = d[g4][j] * S[kb][4 * g4 + j] + sl4[j]; }
            }
          }
          u32x4 stK[2], stQ[2]; float sd = 0.f; bf16x8 vcur[4], vnext[4];
          f32x4 gnr[4];
#pragma unroll
          for (int g4 = 0; g4 < 4; ++g4) gnr[g4] = *(const f32x4*)(p.gla_gn + 32 * wave + 8 * g4 + 4 * hi);
          const bf16_t* vrow = VT + ((size_t)(b * 32) * 1024 + h * 256 + 32 * wave + r32) * 64 + 8 * hi;
#define GLA_LOAD(n_) do { const int m0_ = b * 2048 + 64 * (n_); \
            _Pragma("unroll") for (int i = 0; i < 2; ++i) { const int id = tid + 512 * i; stK[i] = *(const u32x4*)(KdT + ((size_t)(b * 32 + (n_)) * 512 + h * 128 + (id >> 3)) * 64 + (id & 7) * 8); } \
            _Pragma("unroll") for (int i = 0; i < 2; ++i) { const int id = tid + 512 * i; stQ[i] = *(const u32x4*)(Qg + (size_t)(m0_ + (id >> 4)) * 512 + h * 128 + (id & 15) * 8); } \
            if (tid < 128) sd = Decay[(b * 32 + (n_)) * 512 + h * 128 + tid]; \
            _Pragma("unroll") for (int ts = 0; ts < 4; ++ts) vnext[ts] = *(const bf16x8*)(vrow + (size_t)(n_) * 65536 + 16 * ts); } while (0)
#define GLA_STORE(buf_) do { LAS unsigned char* bs_ = lds + (buf_) * G_BUF; \
            _Pragma("unroll") for (int i = 0; i < 2; ++i) { const int id = tid + 512 * i; *(LAS u32x4*)(bs_ + G_KOFF + (id >> 3) * 144 + (id & 7) * 16) = stK[i]; } \
            _Pragma("unroll") for (int i = 0; i < 2; ++i) { const int id = tid + 512 * i; *(LAS u32x4*)(bs_ + G_QOFF + (id >> 4) * 272 + (id & 15) * 16) = stQ[i]; } \
            if (tid < 128) *(LAS float*)(bs_ + G_DOFF + tid * 4) = sd; } while (0)
          LDS_BARRIER();
          GLA_LOAD(n0); GLA_STORE(0);
#pragma unroll
          for (int ts = 0; ts < 4; ++ts) vcur[ts] = vnext[ts];
          GLA_LOAD(n0 + 1);
          LDS_BARRIER();
          for (int n = n0; n < nend; ++n) {
            const LAS unsigned char* base = lds + (n & 1) * G_BUF;
            const int m0 = b * 2048 + 64 * n;
            u32x4 gsr[4];
#pragma unroll
            for (int i = 0; i < 4; ++i) { const int id = tid + 512 * i; gsr[i] = __builtin_nontemporal_load((const u32x4*)(Gs + (size_t)(m0 + (id >> 5)) * 1024 + h * 256 + (id & 31) * 8)); }
#pragma unroll
            for (int kb = 0; kb < 4; ++kb)
#pragma unroll
              for (int g4 = 0; g4 < 4; ++g4) { const f32x4 d4 = *(const LAS f32x4*)(base + G_DOFF + (32 * kb + 8 * g4 + 4 * hi) * 4);
#pragma unroll
                for (int j = 0; j < 4; ++j) S[kb][4 * g4 + j] *= d4[j]; }
#pragma unroll
            for (int ts = 0; ts < 4; ++ts)
#pragma unroll
              for (int kb = 0; kb < 4; ++kb) { const bf16x8 afr = *(const LAS bf16x8*)(base + G_KOFF + (32 * kb + r32) * 144 + (16 * ts + 8 * hi) * 2);
                S[kb] = __builtin_amdgcn_mfma_f32_32x32x16_bf16(afr, vcur[ts], S[kb], 0, 0, 0); }
            f32x16 oT[2];
#pragma unroll
            for (int r = 0; r < 16; ++r) { oT[0][r] = 0.f; oT[1][r] = 0.f; }
#pragma unroll
            for (int kb = 0; kb < 4; ++kb)
#pragma unroll
              for (int s2 = 0; s2 < 2; ++s2) {
                u32x4 w; w.x = pk2(S[kb][8 * s2], S[kb][8 * s2 + 1]); w.y = pk2(S[kb][8 * s2 + 2], S[kb][8 * s2 + 3]); w.z = pk2(S[kb][8 * s2 + 4], S[kb][8 * s2 + 5]); w.w = pk2(S[kb][8 * s2 + 6], S[kb][8 * s2 + 7]);
                const bf16x8 sp = __builtin_bit_cast(bf16x8, w);
#pragma unroll
                for (int tb = 0; tb < 2; ++tb) { const bf16x8 qfr = *(const LAS bf16x8*)(base + G_QOFF + (32 * tb + r32) * 272 + (32 * kb + 16 * s2 + 8 * hi) * 2);
                  oT[tb] = __builtin_amdgcn_mfma_f32_32x32x16_bf16(sp, qfr, oT[tb], 0, 0, 0); }
              }
            LAS float* ssb = (LAS float*)(lds + G_SS) + (n & 1) * 512;
#pragma unroll
            for (int tb = 0; tb < 2; ++tb) { float ss = 0.f;
#pragma unroll
              for (int r = 0; r < 16; ++r) ss += oT[tb][r] * oT[tb][r];
              ss = xor_add32(ss); if (hi == 0) ssb[wave * 64 + 32 * tb + r32] = ss; }
            LDS_BARRIER();
#pragma unroll
            for (int tb = 0; tb < 2; ++tb) { float tot = 0.f;
#pragma unroll
              for (int w = 0; w < 8; ++w) tot += ssb[w * 64 + 32 * tb + r32];
              const float rinv = rsq_(tot * (1.0f / 256.0f) + EPS);
#pragma unroll
              for (int g4 = 0; g4 < 4; ++g4) { const int dv = 32 * wave + 8 * g4 + 4 * hi; const f32x4 gn4 = gnr[g4];
                u32x2 o; o.x = pk2(oT[tb][4 * g4] * rinv * gn4[0], oT[tb][4 * g4 + 1] * rinv * gn4[1]); o.y = pk2(oT[tb][4 * g4 + 2] * rinv * gn4[2], oT[tb][4 * g4 + 3] * rinv * gn4[3]);
                *(LAS u32x2*)(lds + G_OT + (32 * tb + r32) * 528 + dv * 2) = o; } }
            if (n + 1 < nend) GLA_STORE((n + 1) & 1);
#pragma unroll
            for (int ts = 0; ts < 4; ++ts) vcur[ts] = vnext[ts];
            if (n + 2 < nend) GLA_LOAD(n + 2);
            LDS_BARRIER();
#pragma unroll
            for (int i = 0; i < 4; ++i) { const int id = tid + 512 * i; const int row = id >> 5, pc = id & 31;
              float o8[8], g8[8]; unpack8(*(const LAS u32x4*)(lds + G_OT + row * 528 + pc * 16), o8); unpack8(gsr[i], g8);
#pragma unroll
              for (int j = 0; j < 8; ++j) o8[j] *= g8[j];
              *(u32x4*)(Og + (size_t)(m0 + row) * 1024 + h * 256 + pc * 8) = pack8(o8); }
          }
#undef GLA_LOAD
#undef GLA_STORE
        }
      } break;
      case 7: g = pg8::Gemm{(const bf16_t*)(ws + OFF_OG), (const bf16_t*)(ws + OFF_WGOT), MTOK, 1024, 1024}; epi = EPI_YA; break;
      case 8: g = pg8::Gemm{(const bf16_t*)(ws + OFF_CQN), (const bf16_t*)(ws + OFF_WUQT), MTOK, 1536, 256}; epi = EPI_QUP; sync = false; break;
      case 9: g = pg8::Gemm{(const bf16_t*)(ws + OFF_CKVN), (const bf16_t*)(ws + OFF_WUKT), MTOK, 1024, 128}; epi = EPI_KUP; sync = false; break;
      case 10: g = pg8::Gemm{(const bf16_t*)(ws + OFF_WUVT), (const bf16_t*)(ws + OFF_CKVN), 1024, MTOK, 128}; epi = EPI_VUPT; break;
      case 11: sync = false; break;
      case 12: {
        const bf16_t* Q = (const bf16_t*)(ws + OFF_Q); const bf16_t* Kn = (const bf16_t*)(ws + OFF_KNOPE); const bf16_t* KpeR = (const bf16_t*)(ws + OFF_KPER);
        const bf16_t* VmT = (const bf16_t*)(ws + OFF_VMT); const float* KSS = (const float*)(ws + OFF_KSS); const float* KpeSS = (const float*)(ws + OFF_KPESS); bf16_t* Om = (bf16_t*)(ws + OFF_OM);
        constexpr int A_KOFF = 0, A_VOFF = 13312, A_ROFF = 22528, A_BUF = 22784;
        const int r32 = lane & 31, hi = lane >> 5;
        const int pi = (r32 & ~12) | ((r32 & 4) << 1) | ((r32 & 8) >> 1);
        float sbound;
        { float gq = fabsf(p.qn_g[lane]), gk = fabsf(p.kn_g[lane]);
          if (lane < 32) { gq = fmaxf(gq, fabsf(p.qn_g[64 + lane])); gk = fmaxf(gk, fabsf(p.kn_g[64 + lane])); }
          gq = wave_max(gq); gk = wave_max(gk);
          sbound = fminf(9.797958971132712f * 1.4426950408889634f * gq * gk, 60.0f); }
        constexpr int A_GT = 46080;
        __syncthreads();
        if (tid < 96) *(LAS float*)(lds + A_GT + tid * 4) = p.qn_g[tid] * (tid < 64 ? p.kn_g[tid] : 1.0f);
        __syncthreads();
        for (int bh = bx; bh < 256; bh += G) {
          const int b = bh >> 4, h = bh & 15;
          for (int qb = 7; qb >= 0; --qb) {
            const int NT = 4 * qb + 4, cw = 4 * qb + (wave >> 1);
            const int qrow = b * 2048 + 256 * qb + 32 * wave + r32;
            u32x4 sk, sv, sr = {0u, 0u, 0u, 0u}; float srk = 0.f, srk2 = 0.f;
#define ATT_LOAD(t_) do { const int mk_ = b * 2048 + 64 * (t_); \
              sk = *(const u32x4*)(Kn + ((size_t)(b * 16 + h) * 2048 + 64 * (t_) + (tid >> 3)) * 64 + (tid & 7) * 8); \
              if (tid < 256) sr = *(const u32x4*)(KpeR + (size_t)(mk_ + (tid >> 2)) * 32 + (tid & 3) * 8); \
              else if (tid < 320) { srk = KSS[(mk_ + tid - 256) * 16 + h]; srk2 = KpeSS[mk_ + tid - 256]; } \
              sv = *(const u32x4*)(VmT + ((size_t)(b * 32 + (t_)) * 1024 + h * 64 + (tid >> 3)) * 64 + (tid & 7) * 8); } while (0)
#define ATT_STORE(buf_) do { LAS unsigned char* bs_ = lds + (buf_) * A_BUF; \
              *(LAS u32x4*)(bs_ + A_KOFF + (tid >> 3) * 208 + (tid & 7) * 16) = sk; \
              if (tid < 256) *(LAS u32x4*)(bs_ + A_KOFF + (tid >> 2) * 208 + 128 + (tid & 3) * 16) = sr; \
              else if (tid < 320) *(LAS float*)(bs_ + A_ROFF + (tid - 256) * 4) = rsq_((srk + srk2) * (1.0f / 96.0f) + EPS); \
              *(LAS u32x4*)(bs_ + A_VOFF + (tid >> 3) * 144 + (tid & 7) * 16) = sv; } while (0)
            ATT_LOAD(0);
            bf16x8 qf[6];
            {
              int hiq = hi; asm volatile("" : "+v"(hiq));
              u32x4 qraw[6]; float ss = 0.f;
#pragma unroll
              for (int ds = 0; ds < 6; ++ds) qraw[ds] = __builtin_nontemporal_load((const u32x4*)(Q + (size_t)qrow * 1536 + h * 96 + 16 * ds + 8 * hiq));
              const float* cp = cosT + (size_t)qrow * 16 + 8 * hiq; const float* sp = sinT + (size_t)qrow * 16 + 8 * hiq;
              const f32x4 c0 = *(const f32x4*)cp, c1 = *(const f32x4*)(cp + 4), n0 = *(const f32x4*)sp, n1 = *(const f32x4*)(sp + 4);
#pragma unroll
              for (int ds = 0; ds < 6; ++ds) { float t8[8]; unpack8(qraw[ds], t8);
#pragma unroll
                for (int j = 0; j < 8; ++j) ss += t8[j] * t8[j]; }
              ss = xor_add32(ss);
              const float rinv = rsq_(ss * (1.0f / 96.0f) + EPS) * (0.10206207261596575f * 1.4426950408889634f);
              const LAS float* gt = (const LAS float*)(lds + A_GT) + 8 * hiq;
#pragma unroll
              for (int ds = 0; ds < 4; ++ds) {
                const f32x4 a0 = *(const LAS f32x4*)(gt + 16 * ds), a1 = *(const LAS f32x4*)(gt + 16 * ds + 4);
                float t8[8]; unpack8(qraw[ds], t8);
#pragma unroll
                for (int j = 0; j < 4; ++j) { t8[j] *= rinv * a0[j]; t8[4 + j] *= rinv * a1[j]; }
                qf[ds] = __builtin_bit_cast(bf16x8, pack8(t8));
              }
              {
                const f32x4 g10 = *(const LAS f32x4*)(gt + 64), g11 = *(const LAS f32x4*)(gt + 68), g20 = *(const LAS f32x4*)(gt + 80), g21 = *(const LAS f32x4*)(gt + 84);
                float x1[8], x2[8]; unpack8(qraw[4], x1); unpack8(qraw[5], x2);
#pragma unroll
                for (int j = 0; j < 8; ++j) { const float y1 = x1[j] * rinv * (j < 4 ? g10[j & 3] : g11[j & 3]), y2 = x2[j] * rinv * (j < 4 ? g20[j & 3] : g21[j & 3]);
                  const float c = (j < 4 ? c0[j & 3] : c1[j & 3]), sn = (j < 4 ? n0[j & 3] : n1[j & 3]);
                  x1[j] = y1 * c - y2 * sn; x2[j] = y2 * c + y1 * sn; }
                qf[4] = __builtin_bit_cast(bf16x8, pack8(x1)); qf[5] = __builtin_bit_cast(bf16x8, pack8(x2));
              }
            }
            f32x16 o0, o1;
#pragma unroll
            for (int r = 0; r < 16; ++r) { o0[r] = 0.f; o1[r] = 0.f; }
            float l = 0.f;
            ATT_STORE(0); LDS_BARRIER();
            for (int t = 0; t < NT; ++t) {
              if (t + 1 < NT) ATT_LOAD(t + 1);
              if (t <= cw) {
                const LAS unsigned char* base = lds + (t & 1) * A_BUF;
                f32x16 s0, s1;
#pragma unroll
                for (int r = 0; r < 16; ++r) { s0[r] = 0.f; s1[r] = 0.f; }
                bf16x8 ka[3], kc[3], va[4], vc[4];
#pragma unroll
                for (int hf = 0; hf < 2; ++hf) {
#pragma unroll
                  for (int d3 = 0; d3 < 3; ++d3) { const int ds = 3 * hf + d3; ka[d3] = *(const LAS bf16x8*)(base + A_KOFF + pi * 208 + ds * 32 + hi * 16); kc[d3] = *(const LAS bf16x8*)(base + A_KOFF + (32 + pi) * 208 + ds * 32 + hi * 16); }
                  __builtin_amdgcn_sched_barrier(0);
#pragma unroll
                  for (int d3 = 0; d3 < 3; ++d3) {
                    s0 = __builtin_amdgcn_mfma_f32_32x32x16_bf16(ka[d3], qf[3 * hf + d3], s0, 0, 0, 0);
                    s1 = __builtin_amdgcn_mfma_f32_32x32x16_bf16(kc[d3], qf[3 * hf + d3], s1, 0, 0, 0);
                  }
                }
#pragma unroll
                for (int s4 = 0; s4 < 4; ++s4) { va[s4] = *(const LAS bf16x8*)(base + A_VOFF + r32 * 144 + (16 * s4 + 8 * hi) * 2); vc[s4] = *(const LAS bf16x8*)(base + A_VOFF + (32 + r32) * 144 + (16 * s4 + 8 * hi) * 2); }
                const LAS f32x4* rk = (const LAS f32x4*)(base + A_ROFF);
                const f32x4 k00 = rk[2 * hi], k01 = rk[2 * hi + 1], k02 = rk[4 + 2 * hi], k03 = rk[4 + 2 * hi + 1];
                const f32x4 k10 = rk[8 + 2 * hi], k11 = rk[8 + 2 * hi + 1], k12 = rk[12 + 2 * hi], k13 = rk[12 + 2 * hi + 1];
#pragma unroll
                for (int j = 0; j < 4; ++j) {
                  s0[j] = __builtin_amdgcn_exp2f(s0[j] * k00[j] - sbound); s0[4 + j] = __builtin_amdgcn_exp2f(s0[4 + j] * k01[j] - sbound);
                  s0[8 + j] = __builtin_amdgcn_exp2f(s0[8 + j] * k02[j] - sbound); s0[12 + j] = __builtin_amdgcn_exp2f(s0[12 + j] * k03[j] - sbound);
                  s1[j] = __builtin_amdgcn_exp2f(s1[j] * k10[j] - sbound); s1[4 + j] = __builtin_amdgcn_exp2f(s1[4 + j] * k11[j] - sbound);
                  s1[8 + j] = __builtin_amdgcn_exp2f(s1[8 + j] * k12[j] - sbound); s1[12 + j] = __builtin_amdgcn_exp2f(s1[12 + j] * k13[j] - sbound); }
                float ps = 0.f;
#pragma unroll
                for (int r = 0; r < 16; ++r) ps += s0[r] + s1[r];
                l += ps;
#pragma unroll
                for (int s4 = 0; s4 < 4; ++s4) {
                  u32x4 w;
                  if (s4 == 0) { w.x = pk2(s0[0], s0[1]); w.y = pk2(s0[2], s0[3]); w.z = pk2(s0[4], s0[5]); w.w = pk2(s0[6], s0[7]); }
                  else if (s4 == 1) { w.x = pk2(s0[8], s0[9]); w.y = pk2(s0[10], s0[11]); w.z = pk2(s0[12], s0[13]); w.w = pk2(s0[14], s0[15]); }
                  else if (s4 == 2) { w.x = pk2(s1[0], s1[1]); w.y = pk2(s1[2], s1[3]); w.z = pk2(s1[4], s1[5]); w.w = pk2(s1[6], s1[7]); }
                  else { w.x = pk2(s1[8], s1[9]); w.y = pk2(s1[10], s1[11]); w.z = pk2(s1[12], s1[13]); w.w = pk2(s1[14], s1[15]); }
                  const bf16x8 pf = __builtin_bit_cast(bf16x8, w);
                  o0 = __builtin_amdgcn_mfma_f32_32x32x16_bf16(va[s4], pf, o0, 0, 0, 0);
                  o1 = __builtin_amdgcn_mfma_f32_32x32x16_bf16(vc[s4], pf, o1, 0, 0, 0);
                }
              }
              if (t + 1 < NT) ATT_STORE((t + 1) & 1);
              LDS_BARRIER();
            }
            l = xor_add32(l);
            const float li = __builtin_amdgcn_rcpf(l);
            {
              LAS unsigned char* stg = lds + 49152 + wave * 4096;
#pragma unroll
              for (int g4 = 0; g4 < 4; ++g4) {
                u32x2 w0, w1; w0.x = pk2(o0[4 * g4] * li, o0[4 * g4 + 1] * li); w0.y = pk2(o0[4 * g4 + 2] * li, o0[4 * g4 + 3] * li);
                w1.x = pk2(o1[4 * g4] * li, o1[4 * g4 + 1] * li); w1.y = pk2(o1[4 * g4 + 2] * li, o1[4 * g4 + 3] * li);
                *(LAS u32x2*)(stg + r32 * 128 + (8 * g4 + 4 * hi) * 2) = w0; *(LAS u32x2*)(stg + r32 * 128 + 64 + (8 * g4 + 4 * hi) * 2) = w1;
              }
              asm volatile("s_waitcnt lgkmcnt(0)" ::: "memory");
              bf16_t* ow = Om + (size_t)(b * 2048 + 256 * qb + 32 * wave) * 1024 + h * 64;
#pragma unroll
              for (int i = 0; i < 4; ++i) { const int row = i * 8 + (lane >> 3), ch = lane & 7;
                *(u32x4*)(ow + (size_t)row * 1024 + ch * 8) = *(const LAS u32x4*)(stg + row * 128 + ch * 16); }
              asm volatile("s_waitcnt lgkmcnt(0)" ::: "memory");
            }
          }
#undef ATT_LOAD
#undef ATT_STORE
        }
      } break;
      case 13: g = pg8::Gemm{(const bf16_t*)(ws + OFF_OM), (const bf16_t*)(ws + OFF_WMOT), MTOK, 1024, 1024}; epi = EPI_YB; break;
      case 14: g = pg8::Gemm{(const bf16_t*)(ws + OFF_MIX), (const bf16_t*)(ws + OFF_WOUTT), MTOK, 1024, 1024}; epi = EPI_WOUT; break;
      case 15: norm_mod_rows(p.out, p.norm2_g, mod, 3072, 4096, (bf16_t*)(ws + OFF_HB2), gw, NGW, lane); break;
      case 16: g = pg8::Gemm{(const bf16_t*)(ws + OFF_HB2), (const bf16_t*)(ws + OFF_W1T), MTOK, 4096, 1024}; epi = EPI_W1; break;
      case 17: g = pg8::Gemm{(const bf16_t*)(ws + OFF_HID), (const bf16_t*)(ws + OFF_W2T), MTOK, 1024, 4096}; epi = EPI_W2; sync = false; break;
    }
    if (epi >= 0) {
      __syncthreads();
      pg8::StaticOrder S; S.init(g.M, g.N, G, bx);
      EpiSwitch E{epi, ws, p.x, p.out, p.b_merge, p.q_lat_g, p.kv_lat_g, (PROBE_PH == ph && probe_reps == 0) ? 1 : 0};
      int tid2 = threadIdx.x; asm volatile("" : "+v"(tid2));
      pg8::gemm_phase(lds, g, S, E, tid2);
      __syncthreads();
    }
    if (sync) { if (G == 0x7fffffff) grid.sync(); else xcd_barrier(xbar); }
#ifdef PROBE_SYNC
    if (sync) xcd_barrier(xbar);
#endif
    if (ph == PROBE_PH && probe_reps < 1) { ++probe_reps; --ph; }
  }
}

#undef p
extern "C" void kernel_launch(void* const* d_in, const int* in_sizes, int n_in, void* d_out, int out_size, void* d_ws, size_t ws_size, hipStream_t stream) {
  static int grid_blocks = 0;
  if (!grid_blocks) {
    int dev = 0, cus = 0, per_cu = 0;
    (void)hipGetDevice(&dev);
    (void)hipDeviceGetAttribute(&cus, hipDeviceAttributeMultiprocessorCount, dev);
    (void)hipFuncSetAttribute((const void*)fwd_kernel, hipFuncAttributeMaxDynamicSharedMemorySize, (int)LDS_BYTES);
    (void)hipOccupancyMaxActiveBlocksPerMultiprocessor(&per_cu, (const void*)fwd_kernel, 512, LDS_BYTES);
    if (per_cu < 1) per_cu = 1;
    if (per_cu > 1) per_cu = 1;
    grid_blocks = cus * per_cu;
    if (ws_size < WS_END || n_in != 23) { fprintf(stderr, "kernel_launch: unexpected ws_size %zu / n_in %d\n", ws_size, n_in); }
  }
  Params p{};
  p.x = (const float*)d_in[0]; p.c = (const float*)d_in[1]; p.pos = (const int*)d_in[2];
  p.w_ada = (const float*)d_in[3]; p.b_ada = (const float*)d_in[4]; p.norm1_g = (const float*)d_in[5]; p.w_in = (const float*)d_in[6]; p.b_merge = (const float*)d_in[7];
  p.w_alpha = (const float*)d_in[8]; p.b_alpha = (const float*)d_in[9]; p.gla_gn = (const float*)d_in[10]; p.gla_w_o = (const float*)d_in[11];
  p.q_lat_g = (const float*)d_in[12]; p.w_uq = (const float*)d_in[13]; p.kv_lat_g = (const float*)d_in[14]; p.w_ukv = (const float*)d_in[15];
  p.qn_g = (const float*)d_in[16]; p.kn_g = (const float*)d_in[17]; p.mla_w_o = (const float*)d_in[18]; p.w_out = (const float*)d_in[19];
  p.norm2_g = (const float*)d_in[20]; p.w1 = (const float*)d_in[21]; p.w2 = (const float*)d_in[22];
  p.out = (float*)d_out; p.ws = (unsigned char*)d_ws;
  (void)hipMemsetAsync((unsigned char*)d_ws + OFF_CTL, 0, 16384, stream);
  void* args[] = {&p};
  hipError_t e = hipLaunchCooperativeKernel((void*)fwd_kernel, dim3(grid_blocks), dim3(512), args, LDS_BYTES, stream);
  if (e != hipSuccess) fprintf(stderr, "cooperative launch failed: %s (grid %d)\n", hipGetErrorString(e), grid_blocks);
}
```

```cpp
#include <hip/hip_runtime.h>
#include <hip/hip_cooperative_groups.h>
#include <cstdio>
#include <cstdint>
namespace cg = cooperative_groups;

#define LAS __attribute__((address_space(3)))
#define GAS __attribute__((address_space(1)))
typedef unsigned short bf16_t;
typedef short bf16x8 __attribute__((ext_vector_type(8)));
typedef float f32x4 __attribute__((ext_vector_type(4)));
typedef float f32x2 __attribute__((ext_vector_type(2)));
typedef float f32x16 __attribute__((ext_vector_type(16)));
typedef unsigned u32x4 __attribute__((ext_vector_type(4)));
typedef unsigned u32x2 __attribute__((ext_vector_type(2)));
typedef __bf16 bf16x2_t __attribute__((ext_vector_type(2)));

#define DI __device__ __forceinline__
DI unsigned pk2(float lo, float hi) { f32x2 v = {lo, hi}; bf16x2_t b = __builtin_convertvector(v, bf16x2_t); return __builtin_bit_cast(unsigned, b); }
DI unsigned short f2bf(float f) { return (unsigned short)(pk2(f, 0.f) & 0xffffu); }
DI float bflo(unsigned w) { return __uint_as_float(w << 16); }
DI float bfhi(unsigned w) { return __uint_as_float(w & 0xffff0000u); }
DI void unpack8(u32x4 w, float* f) { f[0] = bflo(w.x); f[1] = bfhi(w.x); f[2] = bflo(w.y); f[3] = bfhi(w.y); f[4] = bflo(w.z); f[5] = bfhi(w.z); f[6] = bflo(w.w); f[7] = bfhi(w.w); }
DI u32x4 pack8(const float* f) { u32x4 w; w.x = pk2(f[0], f[1]); w.y = pk2(f[2], f[3]); w.z = pk2(f[4], f[5]); w.w = pk2(f[6], f[7]); return w; }
DI void st_bf8(bf16_t* p, f32x4 a, f32x4 b) { u32x4 w; w.x = pk2(a[0], a[1]); w.y = pk2(a[2], a[3]); w.z = pk2(b[0], b[1]); w.w = pk2(b[2], b[3]); *(u32x4*)p = w; }
template <int CTRL> DI float dpp_f(float x) { return __int_as_float(__builtin_amdgcn_mov_dpp(__float_as_int(x), CTRL, 0xf, 0xf, true)); }
DI float xor_add32(float x) { auto rr = __builtin_amdgcn_permlane32_swap(__float_as_uint(x), __float_as_uint(x), false, false); return __uint_as_float(rr[0]) + __uint_as_float(rr[1]); }
DI float xor_max32(float x) { auto rr = __builtin_amdgcn_permlane32_swap(__float_as_uint(x), __float_as_uint(x), false, false); return fmaxf(__uint_as_float(rr[0]), __uint_as_float(rr[1])); }
DI float xor_add16(float x) { auto rr = __builtin_amdgcn_permlane16_swap(__float_as_uint(x), __float_as_uint(x), false, false); return __uint_as_float(rr[0]) + __uint_as_float(rr[1]); }
DI float row16_sum(float v) { v += dpp_f<0xB1>(v); v += dpp_f<0x4E>(v); v += dpp_f<0x141>(v); v += dpp_f<0x140>(v); return v; }
DI float wave_sum(float v) { v = row16_sum(v); v = xor_add16(v); return xor_add32(v); }
DI float xor_max16(float x) { auto rr = __builtin_amdgcn_permlane16_swap(__float_as_uint(x), __float_as_uint(x), false, false); return fmaxf(__uint_as_float(rr[0]), __uint_as_float(rr[1])); }
DI float wave_max(float v) { v = fmaxf(v, dpp_f<0xB1>(v)); v = fmaxf(v, dpp_f<0x4E>(v)); v = fmaxf(v, dpp_f<0x141>(v)); v = fmaxf(v, dpp_f<0x140>(v)); v = xor_max16(v); return xor_max32(v); }
#define LDS_BARRIER() do { asm volatile("s_waitcnt lgkmcnt(0)" ::: "memory"); __builtin_amdgcn_s_barrier(); asm volatile("" ::: "memory"); } while (0)
DI float sigmoidf_(float x) { return __builtin_amdgcn_rcpf(1.0f + __expf(-x)); }
DI float rsq_(float x) { return __builtin_amdgcn_rsqf(x); }

constexpr int MTOK = 32768, DMODEL = 1024, SEQ = 2048, NBATCH = 16, DFF = 4096;
constexpr float EPS = 1e-6f;
constexpr int INW = 5552;
constexpr int C_GQ = 0, C_GK = 512, C_GV = 1024, C_GG = 2048, C_GA = 3072, C_CQ = 3088, C_CKV = 3344, C_KPE = 3472, C_MG = 3504;

constexpr size_t MB = 1u << 20;
constexpr size_t OFF_MOD = 0, OFF_COS = 1 * MB, OFF_SIN = 3 * MB, OFF_DECAY = 5 * MB, OFF_KPER = 6 * MB, OFF_KPESS = 8 * MB, OFF_KSS = 9 * MB,
                 OFF_KPE = 11 * MB, OFF_ALR = 15 * MB, OFF_CQSS = 17 * MB, OFF_CKVSS = 17 * MB + 256 * 1024, OFF_CTL = 17 * MB + 512 * 1024;
constexpr size_t OFF_WINN = 18 * MB, OFF_WINT = 26 * MB, OFF_WUQT = 29 * MB, OFF_WUKT = 30 * MB, OFF_WUVT = 30 * MB + 256 * 1024, OFF_WGOT = 31 * MB,
                 OFF_WMOT = 33 * MB, OFF_WOUTT = 35 * MB, OFF_W1T = 37 * MB, OFF_W2T = 45 * MB;
constexpr size_t SL1 = 54 * MB, SL2 = 118 * MB, SL3 = 182 * MB, SL4 = 246 * MB, SL5 = 310 * MB, SL6 = 374 * MB;
constexpr size_t OFF_GATEA = SL1, OFF_KNOPE = SL1, OFF_HB2 = SL1;
constexpr size_t OFF_GATEB = SL2, OFF_HID = SL2;
constexpr size_t OFF_GS = SL3, OFF_MIX = SL3;
constexpr size_t OFF_VT = SL4, OFF_VMT = SL4;
constexpr size_t OFF_HB = SL5, OFF_OG = SL5, OFF_OM = SL5;
constexpr size_t OFF_QG = SL6, OFF_KT = SL6 + 32 * MB, OFF_Q = SL6;
constexpr size_t OFF_CQN = 470 * MB, OFF_CKVN = 486 * MB;
constexpr size_t WS_END = 502 * MB;

struct Params {
  const float *x, *c; const int* pos;
  const float *w_ada, *b_ada, *norm1_g, *w_in, *b_merge, *w_alpha, *b_alpha, *gla_gn, *gla_w_o, *q_lat_g, *w_uq, *kv_lat_g, *w_ukv, *qn_g, *kn_g, *mla_w_o,
      *w_out, *norm2_g, *w1, *w2;
  float* out; unsigned char* ws;
};

namespace pg8 {
constexpr int BM = 256, BK = 64, HALF = 128, HTB = HALF * BK * 2, STAGE_BYTES = 8 * HTB, NXCD = 8, WGM = 8;
__host__ __device__ __forceinline__ int lds_byte(int r, int c) { const int st = (r >> 4) * 2 + (c >> 5), rr = r & 15, cc = c & 31, ob = rr * 64 + cc * 2; return st * 1024 + (ob ^ (((ob >> 9) & 1) << 5)); }
__host__ __device__ __forceinline__ void stage_rc(int b, int& R, int& C) { const int st = b / 1024, sb = b % 1024, swz = sb ^ (((sb >> 9) & 1) << 5); R = (st >> 1) * 16 + swz / 64; C = (st & 1) * 32 + (swz % 64) / 2; }
__host__ __device__ __forceinline__ int perm32(int rho) { const int n = rho >> 4, i = rho & 15; return 8 * (i >> 2) + 4 * n + (i & 3); }
struct Unit { int pm, pn; };
struct Gemm { const bf16_t* A; const bf16_t* Bt; int M, N, K; };
struct StaticOrder {
  int nM, nN, nwg, G, c;
  __device__ void init(int M, int N, int G_, int c_) { nM = M / BM; nN = N / BM; nwg = nM * nN; G = G_; c = c_; }
  __device__ bool next(int i, Unit& u) const {
    const long L = (long)i * G + c; if (L >= nwg) return false;
    int wgid = (int)L; { const int q = nwg / NXCD, r = nwg % NXCD, xcd = wgid % NXCD, off = wgid / NXCD; wgid = (xcd < r ? xcd * (q + 1) : r * (q + 1) + (xcd - r) * q) + off; }
    const int nig = WGM * nN, gid = wgid / nig, fm = gid * WGM, gsz = (nM - fm) < WGM ? (nM - fm) : WGM;
    u.pm = fm + ((wgid % nig) % gsz); u.pn = (wgid % nig) / gsz; return true;
  }
};
template <class Epi>
__device__ __forceinline__ void gemm_phase(LAS unsigned char* lds, const Gemm g, const StaticOrder& S, const Epi& E, const int tid) {
  const int wid = __builtin_amdgcn_readfirstlane(tid >> 6), lane = tid & 63, wr = wid >> 2, wc = wid & 3, fr = lane & 15, fq = lane >> 4;
  const int K = g.K, nt = K / BK;
  unsigned voffA[2], voffB[2];
#pragma unroll
  for (int i = 0; i < 2; ++i) { int R, C; stage_rc(tid * 16 + i * 8192, R, C); const int Rb = (R & ~31) + perm32(R & 31);
    voffA[i] = (unsigned)(R * K + C) * 2u; voffB[i] = (unsigned)(Rb * K + C) * 2u; }
  const size_t kstep = (size_t)(BK * 2);
  const size_t hstep = (size_t)HALF * K * 2;
  const size_t tstep = 2 * hstep;
  const unsigned ldsw = (unsigned)wid * 1024u;
  const int aoff = lds_byte(wr * 64 + fr, fq * 8), boff = lds_byte(wc * 32 + fr, fq * 8);
#define PG8_SA(b, h) (((b) * 2 + (h)) * HTB)
#define PG8_SB(b, h) ((4 + (b) * 2 + (h)) * HTB)
#define PG8_STAGE(bufoff, gbase, voff) do { _Pragma("unroll") for (int _i = 0; _i < 2; ++_i) \
    __builtin_amdgcn_global_load_lds((const unsigned*)((const char*)(gbase) + (voff)[_i]), (LAS unsigned*)(lds + (bufoff) + ldsw + _i * 8192), 16, 0, 0); } while (0)
#define PG8_LDA(dst, b, h) do { _Pragma("unroll") for (int m = 0; m < 4; ++m) _Pragma("unroll") for (int k = 0; k < 2; ++k) dst[m][k] = *(const LAS bf16x8*)(lds + PG8_SA(b, h) + aoff + m * 2048 + k * 1024); } while (0)
#define PG8_LDB(dst, b, h) do { _Pragma("unroll") for (int n = 0; n < 2; ++n) _Pragma("unroll") for (int k = 0; k < 2; ++k) dst[n][k] = *(const LAS bf16x8*)(lds + PG8_SB(b, h) + boff + n * 2048 + k * 1024); } while (0)
#define PG8_MMA(ai, bj, At, Bt) do { __builtin_amdgcn_s_setprio(1); _Pragma("unroll") for (int m = 0; m < 4; ++m) _Pragma("unroll") for (int n = 0; n < 2; ++n) _Pragma("unroll") for (int k = 0; k < 2; ++k) \
    acc[ai][bj][m][n] = __builtin_amdgcn_mfma_f32_16x16x32_bf16(Bt[n][k], At[m][k], acc[ai][bj][m][n], 0, 0, 0); __builtin_amdgcn_s_setprio(0); } while (0)
#define PG8_WAIT_V(n) asm volatile("s_waitcnt vmcnt(" #n ")" ::: "memory")
#define PG8_WAIT_L(n) asm volatile("s_waitcnt lgkmcnt(" #n ")" ::: "memory")
#define PG8_BAR __builtin_amdgcn_s_barrier()
#define PG8_SCHED __builtin_amdgcn_sched_barrier(0)
  Unit cur, nxt; int ui = 0;
  if (!S.next(0, cur)) return;
  f32x4 acc[2][2][4][2];
#pragma unroll
  for (int a = 0; a < 2; ++a)
#pragma unroll
    for (int b = 0; b < 2; ++b)
#pragma unroll
      for (int m = 0; m < 4; ++m)
#pragma unroll
        for (int n = 0; n < 2; ++n) acc[a][b][m][n] = (f32x4){0.f, 0.f, 0.f, 0.f};
  bf16x8 At[4][2], B0[2][2], B1[2][2];
  const char* cA = (const char*)g.A + (size_t)cur.pm * tstep; const char* cB = (const char*)g.Bt + (size_t)cur.pn * tstep;
  PG8_STAGE(PG8_SB(0, 0), cB, voffB); PG8_STAGE(PG8_SB(0, 1), cB + hstep, voffB); PG8_STAGE(PG8_SA(0, 0), cA, voffA); PG8_STAGE(PG8_SA(0, 1), cA + hstep, voffA);
  if (wr == 1) PG8_BAR;
  PG8_WAIT_V(2); PG8_BAR;
  PG8_STAGE(PG8_SB(1, 0), cB + kstep, voffB); PG8_STAGE(PG8_SA(1, 0), cA + kstep, voffA); PG8_STAGE(PG8_SB(1, 1), cB + hstep + kstep, voffB);
  PG8_WAIT_V(6); PG8_BAR;
  for (;;) {
    const bool has_next = S.next(ui + 1, nxt);
    const char* nA = has_next ? (const char*)g.A + (size_t)nxt.pm * tstep : cA; const char* nB = has_next ? (const char*)g.Bt + (size_t)nxt.pn * tstep : cB;
    for (int t = 0; t < nt; t += 2) {
      const bool last = (t == nt - 2);
      const char* a1 = cA + (size_t)(t + 1) * kstep;
      const char* a2 = last ? nA : cA + (size_t)(t + 2) * kstep; const char* b2 = last ? nB : cB + (size_t)(t + 2) * kstep;
      const char* a3 = a2 + kstep; const char* b3 = b2 + kstep;
      PG8_LDB(B0, 0, 0); PG8_LDB(B1, 0, 1); PG8_SCHED; PG8_LDA(At, 0, 0); PG8_STAGE(PG8_SA(1, 1), a1 + hstep, voffA);
      PG8_WAIT_V(8); PG8_WAIT_L(0); PG8_BAR; PG8_MMA(0, 0, At, B0); PG8_MMA(0, 1, At, B1); PG8_BAR; PG8_SCHED;
      PG8_LDA(At, 0, 1); PG8_STAGE(PG8_SB(0, 0), b2, voffB); PG8_STAGE(PG8_SB(0, 1), b2 + hstep, voffB); PG8_STAGE(PG8_SA(0, 0), a2, voffA);
      PG8_WAIT_V(8); PG8_WAIT_L(0); PG8_BAR; PG8_MMA(1, 0, At, B0); PG8_MMA(1, 1, At, B1); PG8_BAR; PG8_SCHED;
      PG8_LDB(B0, 1, 0); PG8_LDB(B1, 1, 1); PG8_SCHED; PG8_LDA(At, 1, 0); PG8_STAGE(PG8_SA(0, 1), a2 + hstep, voffA);
      PG8_WAIT_V(8); PG8_WAIT_L(0); PG8_BAR; PG8_MMA(0, 0, At, B0); PG8_MMA(0, 1, At, B1); PG8_BAR; PG8_SCHED;
      PG8_LDA(At, 1, 1); PG8_STAGE(PG8_SB(1, 0), b3, voffB); PG8_STAGE(PG8_SB(1, 1), b3 + hstep, voffB); PG8_STAGE(PG8_SA(1, 0), a3, voffA);
      PG8_WAIT_V(8); PG8_WAIT_L(0); PG8_BAR; PG8_MMA(1, 0, At, B0); PG8_MMA(1, 1, At, B1); PG8_BAR; PG8_SCHED;
    }
    if (wr == 0) PG8_BAR;
#pragma unroll
    for (int ai = 0; ai < 2; ++ai)
#pragma unroll
      for (int m = 0; m < 4; ++m) {
        const int row = cur.pm * BM + ai * HALF + wr * 64 + m * 16 + fr;
#pragma unroll
        for (int bj = 0; bj < 2; ++bj) E(row, cur.pn * BM + bj * HALF + wc * 32 + 8 * fq, acc[ai][bj][m][0], acc[ai][bj][m][1]);
      }
    if (!has_next) break;
#pragma unroll
    for (int a = 0; a < 2; ++a)
#pragma unroll
      for (int b = 0; b < 2; ++b)
#pragma unroll
        for (int m = 0; m < 4; ++m)
#pragma unroll
          for (int n = 0; n < 2; ++n) acc[a][b][m][n] = (f32x4){0.f, 0.f, 0.f, 0.f};
    cur = nxt; cA = nA; cB = nB; ++ui;
    if (wr == 1) PG8_BAR;
  }
  PG8_WAIT_V(0);
  PG8_BAR;
#undef PG8_SA
#undef PG8_SB
#undef PG8_STAGE
#undef PG8_LDA
#undef PG8_LDB
#undef PG8_MMA
#undef PG8_WAIT_V
#undef PG8_WAIT_L
#undef PG8_BAR
#undef PG8_SCHED
}
}

enum { EPI_PROJN = 0, EPI_PROJT, EPI_YA, EPI_QUP, EPI_KUP, EPI_VUPT, EPI_YB, EPI_WOUT, EPI_W1, EPI_W2 };
struct EpiSwitch {
  int id; unsigned char* ws; const float* x; float* out; const float* b_merge; const float* q_lat_g; const float* kv_lat_g; int dry;
  DI void operator()(int row, int col, f32x4 v0, f32x4 v1) const {
    switch (id) {
      case EPI_PROJN: {
        if (col < 512) { const float s = 0.08838834764831845f; st_bf8((bf16_t*)(ws + OFF_QG) + (size_t)row * 512 + col, v0 * s, v1 * s); }
        else if (col < 1536) {
#pragma unroll
          for (int i = 0; i < 4; ++i) { v0[i] = v0[i] * sigmoidf_(v0[i]); v1[i] = v1[i] * sigmoidf_(v1[i]); }
          st_bf8((bf16_t*)(ws + OFF_GS) + (size_t)row * 1024 + (col - 512), v0, v1);
        } else if (col < 3584) {
          const int c2 = col - 1536; const f32x4 b0 = *(const f32x4*)(b_merge + c2), b1 = *(const f32x4*)(b_merge + c2 + 4);
#pragma unroll
          for (int i = 0; i < 4; ++i) { v0[i] = sigmoidf_(v0[i] + b0[i]); v1[i] = sigmoidf_(v1[i] + b1[i]); }
          bf16_t* dst = (c2 < 1024) ? (bf16_t*)(ws + OFF_GATEA) + (size_t)row * 1024 + c2 : (bf16_t*)(ws + OFF_GATEB) + (size_t)row * 1024 + (c2 - 1024);
          st_bf8(dst, v0, v1);
        } else if (col < 3968) {
          const bool isq = col < 3840; const int c2 = isq ? col - 3584 : col - 3840; const float* gp = (isq ? q_lat_g : kv_lat_g) + c2;
          const f32x4 g0 = *(const f32x4*)gp, g1 = *(const f32x4*)(gp + 4);
          float ss = (v0[0] * v0[0] + v0[1] * v0[1]) + (v0[2] * v0[2] + v0[3] * v0[3]) + (v1[0] * v1[0] + v1[1] * v1[1]) + (v1[2] * v1[2] + v1[3] * v1[3]);
          ss = xor_add16(ss); ss = xor_add32(ss);
          bf16_t* dst = isq ? (bf16_t*)(ws + OFF_CQN) + (size_t)row * 256 + c2 : (bf16_t*)(ws + OFF_CKVN) + (size_t)row * 128 + c2;
          st_bf8(dst, v0 * g0, v1 * g1);
          if ((threadIdx.x & 48) == 0) atomicAdd((float*)(ws + (isq ? OFF_CQSS : OFF_CKVSS)) + row, ss);
        }
        else if (col < 4000) { float* d = (float*)(ws + OFF_KPE) + (size_t)row * 32 + (col - 3968); *(f32x4*)d = v0; *(f32x4*)(d + 4) = v1; }
        else if (col < 4016) { float* d = (float*)(ws + OFF_ALR) + (size_t)row * 16 + (col - 4000); *(f32x4*)d = v0; *(f32x4*)(d + 4) = v1; }
      } break;
      case EPI_PROJT: {
        bf16_t* dst = (row < 512) ? (bf16_t*)(ws + OFF_KT) + ((size_t)(col >> 6) * 512 + row) * 64 + (col & 63) : (bf16_t*)(ws + OFF_VT) + ((size_t)(col >> 6) * 1024 + (row - 512)) * 64 + (col & 63);
        st_bf8(dst, v0, v1);
      } break;
      case EPI_YA: {
        const u32x4 gw = __builtin_nontemporal_load((const u32x4*)((const bf16_t*)(ws + OFF_GATEA) + (size_t)row * 1024 + col)); float g[8]; unpack8(gw, g);
#pragma unroll
        for (int i = 0; i < 4; ++i) { v0[i] *= g[i]; v1[i] *= g[4 + i]; }
        st_bf8((bf16_t*)(ws + OFF_MIX) + (size_t)row * 1024 + col, v0, v1);
      } break;
      case EPI_QUP: { const float al = rsq_(((const float*)(ws + OFF_CQSS))[row] * (1.0f / 256.0f) + EPS);
        st_bf8((bf16_t*)(ws + OFF_Q) + (size_t)row * 1536 + col, v0 * al, v1 * al); } break;
      case EPI_KUP: { const float al = rsq_(((const float*)(ws + OFF_CKVSS))[row] * (1.0f / 128.0f) + EPS);
        v0 = v0 * al; v1 = v1 * al;
        float ss = (v0[0] * v0[0] + v0[1] * v0[1]) + (v0[2] * v0[2] + v0[3] * v0[3]) + (v1[0] * v1[0] + v1[1] * v1[1]) + (v1[2] * v1[2] + v1[3] * v1[3]);
        ss = xor_add16(ss); ss = xor_add32(ss);
        st_bf8((bf16_t*)(ws + OFF_KNOPE) + ((size_t)((row >> 11) * 16 + (col >> 6)) * 2048 + (row & 2047)) * 64 + (col & 63), v0, v1);
        if ((threadIdx.x & 48) == 0) atomicAdd((float*)(ws + OFF_KSS) + (size_t)row * 16 + (col >> 6), ss); } break;
      case EPI_VUPT: { const float* cs = (const float*)(ws + OFF_CKVSS) + col; const f32x4 c0 = *(const f32x4*)cs, c1 = *(const f32x4*)(cs + 4);
#pragma unroll
        for (int i = 0; i < 4; ++i) { v0[i] *= rsq_(c0[i] * (1.0f / 128.0f) + EPS); v1[i] *= rsq_(c1[i] * (1.0f / 128.0f) + EPS); }
        st_bf8((bf16_t*)(ws + OFF_VMT) + ((size_t)(col >> 6) * 1024 + row) * 64 + (col & 63), v0, v1); } break;
      case EPI_YB: {
        const u32x4 gw = __builtin_nontemporal_load((const u32x4*)((const bf16_t*)(ws + OFF_GATEB) + (size_t)row * 1024 + col)); float g[8]; unpack8(gw, g);
        bf16_t* mp = (bf16_t*)(ws + OFF_MIX) + (size_t)row * 1024 + col; const u32x4 tw = *(const u32x4*)mp; float t[8]; unpack8(tw, t);
#pragma unroll
        for (int i = 0; i < 4; ++i) { v0[i] = t[i] + v0[i] * g[i]; v1[i] = t[4 + i] + v1[i] * g[4 + i]; }
        st_bf8(dry ? (bf16_t*)(ws + SL4) + (size_t)row * 1024 + col : mp, v0, v1);
      } break;
      case EPI_WOUT: {
        const float* mod = (const float*)(ws + OFF_MOD) + (size_t)(row >> 11) * 6144 + 2048 + col;
        const f32x4 g0 = *(const f32x4*)mod, g1 = *(const f32x4*)(mod + 4);
        const float* xp = x + (size_t)row * 1024 + col; const f32x4 x0 = __builtin_nontemporal_load((const f32x4*)xp), x1 = __builtin_nontemporal_load((const f32x4*)(xp + 4));
        float* op = out + (size_t)row * 1024 + col; *(f32x4*)op = x0 + g0 * v0; *(f32x4*)(op + 4) = x1 + g1 * v1;
      } break;
      case EPI_W1: {
#pragma unroll
        for (int i = 0; i < 4; ++i) { const float a = fmaxf(v0[i], 0.f), b = fmaxf(v1[i], 0.f); v0[i] = a * a; v1[i] = b * b; }
        st_bf8((bf16_t*)(ws + OFF_HID) + (size_t)row * 4096 + col, v0, v1);
      } break;
      case EPI_W2: {
        const float* mod = (const float*)(ws + OFF_MOD) + (size_t)(row >> 11) * 6144 + 5120 + col;
        const f32x4 g0 = *(const f32x4*)mod, g1 = *(const f32x4*)(mod + 4);
        float* op = out + (size_t)row * 1024 + col; const f32x4 x0 = *(const f32x4*)op, x1 = *(const f32x4*)(op + 4);
        if (dry) op = (float*)(ws + SL6) + (size_t)row * 1024 + col;
        __builtin_nontemporal_store(x0 + g0 * v0, (f32x4*)op); __builtin_nontemporal_store(x1 + g1 * v1, (f32x4*)(op + 4));
      } break;
    }
  }
};

DI void tr_item(const float* __restrict__ src, int ld, int col0, int gs, int nvalid, int nrows, int K, bf16_t* dst, LAS float* scr, int item, int lane, bool sw23 = false) {
  const int nblk = nrows / 32, kb = item / nblk, nb = item % nblk, k0 = 64 * kb, n0 = 32 * nb;
  const int n = n0 + (lane & 31); const int ns = sw23 ? ((n & ~12) | ((n & 4) << 1) | ((n & 8) >> 1)) : n; const int scol = col0 + (ns >> 6) * gs + (ns & 63); const bool ok = n < nvalid;
#pragma unroll
  for (int i = 0; i < 32; ++i) { const int kk = 2 * i + (lane >> 5); scr[kk * 33 + (lane & 31)] = ok ? __builtin_nontemporal_load(&src[(size_t)(k0 + kk) * ld + scol]) : 0.f; }
  asm volatile("s_waitcnt lgkmcnt(0)" ::: "memory");
  const int c = lane & 7;
#pragma unroll
  for (int j = 0; j < 4; ++j) { const int nn = (lane >> 3) + 8 * j; const LAS float* s = scr + (8 * c) * 33 + nn;
    u32x4 o; o.x = pk2(s[0 * 33], s[1 * 33]); o.y = pk2(s[2 * 33], s[3 * 33]); o.z = pk2(s[4 * 33], s[5 * 33]); o.w = pk2(s[6 * 33], s[7 * 33]);
    *(u32x4*)(dst + (size_t)(n0 + nn) * K + k0 + 8 * c) = o; }
  asm volatile("s_waitcnt lgkmcnt(0)" ::: "memory");
}

DI void norm_mod_rows(const float* __restrict__ X, const float* __restrict__ g, const float* __restrict__ mod, int shift_off, int scale_off, bf16_t* __restrict__ H, int gw, int NGW, int lane) {
  for (int m = gw; m < MTOK; m += 2 * NGW) {
    f32x4 v[2][4]; float s[2];
#pragma unroll
    for (int r = 0; r < 2; ++r) { const int mr = (m + r * NGW < MTOK) ? m + r * NGW : m; const f32x4* xr = (const f32x4*)(X + (size_t)mr * 1024) + lane;
#pragma unroll
      for (int j = 0; j < 4; ++j) v[r][j] = __builtin_nontemporal_load(&xr[64 * j]); }
#pragma unroll
    for (int r = 0; r < 2; ++r) { float a = 0.f;
#pragma unroll
      for (int j = 0; j < 4; ++j) a += (v[r][j][0] * v[r][j][0] + v[r][j][1] * v[r][j][1]) + (v[r][j][2] * v[r][j][2] + v[r][j][3] * v[r][j][3]);
      s[r] = a; }
    s[0] = wave_sum(s[0]); s[1] = wave_sum(s[1]);
#pragma unroll
    for (int r = 0; r < 2; ++r) {
      const int mm = (m + r * NGW < MTOK) ? m + r * NGW : m, b = mm >> 11; const float rinv = rsq_(s[r] * (1.0f / 1024.0f) + EPS);
#pragma unroll
      for (int j = 0; j < 4; ++j) { const int col = 4 * lane + 256 * j;
        const f32x4 g4 = *(const f32x4*)(g + col), sc = *(const f32x4*)(mod + b * 6144 + scale_off + col), sh = *(const f32x4*)(mod + b * 6144 + shift_off + col);
        f32x4 o = v[r][j] * rinv * g4 * (sc + 1.0f) + sh;
        u32x2 w; w.x = pk2(o[0], o[1]); w.y = pk2(o[2], o[3]); *(u32x2*)(H + (size_t)mm * 1024 + col) = w; }
    }
  }
}

#define XB_TMO      128
#define XB_XCNT(j)  (256  + 64 * (j))
#define XB_XSUB(j)  (1280 + 64 * (j))
#define XB_XGEN(j)  (2304 + 64 * (j))
#define XB_TOP      3328
#define XB_TOPGEN   3392
#define XCD_BAR_WORDS 3456
#define XB_SPIN_CAP (1u << 18)
DI unsigned xb_ld(unsigned* p) { return __hip_atomic_load(p, __ATOMIC_RELAXED, __HIP_MEMORY_SCOPE_AGENT); }
DI unsigned xb_add(unsigned* p, unsigned v) { return __hip_atomic_fetch_add(p, v, __ATOMIC_RELAXED, __HIP_MEMORY_SCOPE_AGENT); }
DI unsigned xb_xcc_id() { return (unsigned)__builtin_amdgcn_s_getreg((3 << 11) | 20) & 0xFu; }
#define XB_SPIN(cond, bar) do { unsigned _sp = 0; while (cond) { __builtin_amdgcn_s_sleep(1); \
    if ((++_sp & 255u) == 0u) { if (xb_ld(&(bar)[XB_TMO])) break; if (_sp > XB_SPIN_CAP) { atomicAdd(&(bar)[XB_TMO], 1u); break; } } } } while (0)
struct XcdBarrier { unsigned* bar; unsigned x; volatile LAS unsigned* st; };
DI XcdBarrier xcd_barrier_post(unsigned* bar, volatile LAS unsigned* st) {
  XcdBarrier b; b.bar = bar; b.x = xb_xcc_id(); b.st = st;
  if (threadIdx.x == 0) (void)xb_add(&bar[XB_XCNT(b.x)], 1u);
  return b;
}
DI void xcd_barrier_complete(unsigned* bar, unsigned x, unsigned& nloc, unsigned& nx) {
  const unsigned G = gridDim.x * gridDim.y * gridDim.z;
  unsigned sum, cnt, mine, sp = 0u;
  for (;;) {
    sum = 0u; cnt = 0u; mine = 0u;
#pragma unroll
    for (unsigned j = 0; j < 16; ++j) { const unsigned c = xb_ld(&bar[XB_XCNT(j)]); sum += c; cnt += (c > 0u) ? 1u : 0u; mine = (j == x) ? c : mine; }
    if (sum == G) break;
    __builtin_amdgcn_s_sleep(1);
    if ((++sp & 255u) == 0u) { if (xb_ld(&bar[XB_TMO])) break; if (sp > XB_SPIN_CAP) { atomicAdd(&bar[XB_TMO], 1u); break; } }
  }
  nloc = mine > 0u ? mine : 1u; nx = cnt > 0u ? cnt : 1u;
}
DI void xcd_barrier(const XcdBarrier& b) {
  asm volatile("s_waitcnt vmcnt(0)" ::: "memory");
  __syncthreads();
  if (threadIdx.x == 0) {
    unsigned* bar = b.bar;
    __builtin_amdgcn_s_waitcnt(0);
    unsigned nloc = b.st[0], nx = b.st[1];
    if (nloc == 0u) { xcd_barrier_complete(bar, b.x, nloc, nx); b.st[0] = nloc; b.st[1] = nx; }
    const unsigned old = xb_add(&bar[XB_XSUB(b.x)], 1u);
    const unsigned gen = old / nloc;
    if (old + 1u == (gen + 1u) * nloc) {
      __builtin_amdgcn_fence(__ATOMIC_RELEASE, "agent");
      asm volatile("s_waitcnt vmcnt(0)" ::: "memory");
      const unsigned og = xb_add(&bar[XB_TOP], 1u);
      const unsigned tg = og / nx;
      if (og + 1u == (tg + 1u) * nx) xb_add(&bar[XB_TOPGEN], 1u);
      else XB_SPIN(xb_ld(&bar[XB_TOPGEN]) == tg, bar);
      __builtin_amdgcn_fence(__ATOMIC_ACQUIRE, "agent");
      xb_add(&bar[XB_XGEN(b.x)], 1u);
      asm volatile("s_waitcnt vmcnt(0)" ::: "memory");
    } else {
      XB_SPIN(xb_ld(&bar[XB_XGEN(b.x)]) == gen, bar);
      __builtin_amdgcn_fence(__ATOMIC_ACQUIRE, "agent");
      asm volatile("s_waitcnt vmcnt(0)" ::: "memory");
    }
  }
  __syncthreads();
}

constexpr int NPH = 18;
#ifndef PROBE_PH
#define PROBE_PH -1
#endif
constexpr size_t LDS_BYTES = 151552;

__global__ void __launch_bounds__(512, 2) fwd_kernel(Params p_in) {
  extern __shared__ __attribute__((aligned(16))) unsigned char lds_raw[];
  LAS unsigned char* lds = (LAS unsigned char*)lds_raw;
  cg::grid_group grid = cg::this_grid();
  volatile LAS unsigned* bar_st = (volatile LAS unsigned*)(lds + 151040);
  if (threadIdx.x < 2) bar_st[threadIdx.x] = 0u;
  __syncthreads();
  const XcdBarrier xbar = xcd_barrier_post((unsigned*)(p_in.ws + OFF_CTL), bar_st);
  int probe_reps = 0;
  for (int ph = 0; ph < NPH; ++ph) {
    int tid = threadIdx.x; asm volatile("" : "+v"(tid));
    int bx = blockIdx.x; asm volatile("" : "+s"(bx));
    int G = gridDim.x; asm volatile("" : "+s"(G));
    const __attribute__((address_space(4))) Params* kp = (const __attribute__((address_space(4))) Params*)__builtin_amdgcn_kernarg_segment_ptr(); asm volatile("" : "+s"(kp));
#define p (*kp)
    GAS unsigned char* wsg = (GAS unsigned char*)p.ws; asm volatile("" : "+s"(wsg)); unsigned char* ws = (unsigned char*)wsg;
    const int lane = tid & 63, wave = __builtin_amdgcn_readfirstlane(tid >> 6);
    const int gw = bx * 8 + wave, NGW = G * 8;
    float* mod = (float*)(ws + OFF_MOD);
    float* cosT = (float*)(ws + OFF_COS); float* sinT = (float*)(ws + OFF_SIN);
    pg8::Gemm g{nullptr, nullptr, 0, 0, 0}; int epi = -1; bool sync = true;
    switch (ph) {
      case 0: {
        LAS float* lf = (LAS float*)lds;
        LAS float* scr = lf + wave * (64 * 33);
        LAS float* sc = lf + 16896;
        if (bx < 192) {
#pragma unroll 8
          for (int idx = tid; idx < 16384; idx += 512) { const int b = idx >> 10, k = idx & 1023; const float cv = p.c[idx]; sc[k * 16 + b] = cv * __builtin_amdgcn_rcpf(1.0f + __expf(-cv)); } }
        bf16_t* WinN = (bf16_t*)(ws + OFF_WINN); bf16_t* WinT = (bf16_t*)(ws + OFF_WINT);
        constexpr int I1 = 256, I2 = 512, I3 = 1024, I4 = 128, I5 = 64, I6 = 16, I7 = 48, I8 = 256, I9 = 512, I10 = 192, I11 = 64, I12 = 64, I13 = 512, I14 = 512, I15 = 512, I16 = 2048, I17 = 2048;
        constexpr int NIT = I1 + I2 + I3 + I4 + I5 + I6 + I7 + I8 + I9 + I10 + I11 + I12 + I13 + I14 + I15 + I16 + I17;
        for (int it = gw; it < NIT; it += NGW) {
          int r = it;
          if (r < I1) { tr_item(p.w_in, INW, C_GQ, 64, 512, 512, 1024, WinN, scr, r, lane, true); continue; } r -= I1;
          if (r < I2) { tr_item(p.w_in, INW, C_GG, 64, 1024, 1024, 1024, WinN + (size_t)512 * 1024, scr, r, lane); continue; } r -= I2;
          if (r < I3) { tr_item(p.w_in, INW, C_MG, 64, 2048, 2048, 1024, WinN + (size_t)1536 * 1024, scr, r, lane); continue; } r -= I3;
          if (r < I4) { tr_item(p.w_in, INW, C_CQ, 64, 256, 256, 1024, WinN + (size_t)3584 * 1024, scr, r, lane); continue; } r -= I4;
          if (r < I5) { tr_item(p.w_in, INW, C_CKV, 64, 128, 128, 1024, WinN + (size_t)3840 * 1024, scr, r, lane); continue; } r -= I5;
          if (r < I6) { tr_item(p.w_in, INW, C_KPE, 64, 32, 32, 1024, WinN + (size_t)3968 * 1024, scr, r, lane); continue; } r -= I6;
          if (r < I7) { tr_item(p.w_in, INW, C_GA, 64, 16, 96, 1024, WinN + (size_t)4000 * 1024, scr, r, lane); continue; } r -= I7;
          if (r < I8) { tr_item(p.w_in, INW, C_GK, 64, 512, 512, 1024, WinT, scr, r, lane); continue; } r -= I8;
          if (r < I9) { tr_item(p.w_in, INW, C_GV, 64, 1024, 1024, 1024, WinT + (size_t)512 * 1024, scr, r, lane); continue; } r -= I9;
          if (r < I10) { tr_item(p.w_uq, 1536, 0, 64, 1536, 1536, 256, (bf16_t*)(ws + OFF_WUQT), scr, r, lane); continue; } r -= I10;
          if (r < I11) { tr_item(p.w_ukv, 2048, 0, 128, 1024, 1024, 128, (bf16_t*)(ws + OFF_WUKT), scr, r, lane); continue; } r -= I11;
          if (r < I12) { tr_item(p.w_ukv, 2048, 64, 128, 1024, 1024, 128, (bf16_t*)(ws + OFF_WUVT), scr, r, lane); continue; } r -= I12;
          if (r < I13) { tr_item(p.gla_w_o, 1024, 0, 64, 1024, 1024, 1024, (bf16_t*)(ws + OFF_WGOT), scr, r, lane); continue; } r -= I13;
          if (r < I14) { tr_item(p.mla_w_o, 1024, 0, 64, 1024, 1024, 1024, (bf16_t*)(ws + OFF_WMOT), scr, r, lane); continue; } r -= I14;
          if (r < I15) { tr_item(p.w_out, 1024, 0, 64, 1024, 1024, 1024, (bf16_t*)(ws + OFF_WOUTT), scr, r, lane); continue; } r -= I15;
          if (r < I16) { tr_item(p.w1, 4096, 0, 64, 4096, 4096, 1024, (bf16_t*)(ws + OFF_W1T), scr, r, lane); continue; } r -= I16;
          tr_item(p.w2, 1024, 0, 64, 1024, 1024, 4096, (bf16_t*)(ws + OFF_W2T), scr, r, lane);
        }
        for (int idx = bx * 512 + tid; idx < MTOK * 16; idx += G * 512) ((float*)(ws + OFF_KSS))[idx] = 0.f;
        for (int idx = bx * 512 + tid; idx < MTOK; idx += G * 512) { ((float*)(ws + OFF_CQSS))[idx] = 0.f; ((float*)(ws + OFF_CKVSS))[idx] = 0.f; }
#pragma unroll 4
        for (int idx = bx * 512 + tid; idx < MTOK * 16; idx += G * 512) {
          const int m = idx >> 4, i = idx & 15;
          const float freq = exp2f(-(float)i * 0.83048202372184058f);
          const float ang = (float)p.pos[m] * freq;
          double rev = (double)ang * 0.15915494309189535; rev -= rint(rev);
          const float fr = (float)rev;
          cosT[idx] = __builtin_amdgcn_cosf(fr); sinT[idx] = __builtin_amdgcn_sinf(fr);
        }
        __syncthreads();
        for (int u = bx; u < 192; u += G) {
          const int col = u * 32 + (lane & 31), k0 = wave * 128 + (lane >> 5);
          float acc[16];
#pragma unroll
          for (int b = 0; b < 16; ++b) acc[b] = 0.f;
#pragma unroll 16
          for (int i = 0; i < 64; ++i) {
            const int k = k0 + 2 * i;
            const float w = __builtin_nontemporal_load(&p.w_ada[(size_t)k * 6144 + col]);
            const LAS f32x4* s4 = (const LAS f32x4*)(sc + k * 16);
#pragma unroll
            for (int q = 0; q < 4; ++q) { const f32x4 sv4 = s4[q]; acc[4 * q] += sv4[0] * w; acc[4 * q + 1] += sv4[1] * w; acc[4 * q + 2] += sv4[2] * w; acc[4 * q + 3] += sv4[3] * w; }
          }
          LAS float* red = lf;
#pragma unroll
          for (int b = 0; b < 16; ++b) { const float t = xor_add32(acc[b]); if (lane < 32) red[(wave * 16 + b) * 32 + lane] = t; }
          __syncthreads();
          { const int o = tid; const int b = o >> 5, l = o & 31; float sum = p.b_ada[u * 32 + l];
#pragma unroll
            for (int w = 0; w < 8; ++w) sum += red[(w * 16 + b) * 32 + l];
            mod[b * 6144 + u * 32 + l] = sum; }
          __syncthreads();
        }
      } break;
      case 1: norm_mod_rows(p.x, p.norm1_g, mod, 0, 1024, (bf16_t*)(ws + OFF_HB), gw, NGW, lane); break;
      case 2: g = pg8::Gemm{(const bf16_t*)(ws + OFF_HB), (const bf16_t*)(ws + OFF_WINN), MTOK, 4096, 1024}; epi = EPI_PROJN; sync = false; break;
      case 3: g = pg8::Gemm{(const bf16_t*)(ws + OFF_WINT), (const bf16_t*)(ws + OFF_HB), 1536, MTOK, 1024}; epi = EPI_PROJT; break;
      case 4: {
        const float* KPE = (const float*)(ws + OFF_KPE); bf16_t* KpeR = (bf16_t*)(ws + OFF_KPER); float* KpeSS = (float*)(ws + OFF_KPESS);
        for (int idx = bx * 512 + tid; idx < MTOK * 16; idx += G * 512) {
          const int m = idx >> 4, i = idx & 15;
          const float x1 = KPE[(size_t)m * 32 + i], x2 = KPE[(size_t)m * 32 + 16 + i];
          const float y1 = x1 * p.kn_g[64 + i], y2 = x2 * p.kn_g[80 + i]; const float c = cosT[idx], sn = sinT[idx];
          KpeR[(size_t)m * 32 + i] = f2bf(y1 * c - y2 * sn); KpeR[(size_t)m * 32 + 16 + i] = f2bf(y2 * c + y1 * sn);
          float ss = row16_sum(x1 * x1 + x2 * x2);
          if (i == 0) KpeSS[m] = ss;
        }
        bf16_t* KT = (bf16_t*)(ws + OFF_KT); const float* ALR = (const float*)(ws + OFF_ALR); float* Decay = (float*)(ws + OFF_DECAY);
        for (int c = bx; c < 512; c += G) {
          const int m0 = c * 64, pc = tid & 7, fl = tid >> 3;
          f32x4 alr[8][4];
#pragma unroll
          for (int j = 0; j < 8; ++j)
#pragma unroll
            for (int q = 0; q < 4; ++q) alr[j][q] = *(const f32x4*)(ALR + (size_t)(m0 + 8 * pc + j) * 16 + 4 * q);
          for (int rb = 0; rb < 8; ++rb) {
            const int f = rb * 64 + fl;
            float w[16];
#pragma unroll
            for (int r = 0; r < 16; ++r) w[r] = p.w_alpha[r * 512 + f];
            const float ba = p.b_alpha[f];
            u32x4* kp = (u32x4*)(KT + ((size_t)c * 512 + f) * 64 + 8 * pc);
            float kv[8]; unpack8(*kp, kv);
            float la[8]; float tot = 0.f;
#pragma unroll
            for (int j = 0; j < 8; ++j) { float z = ba;
#pragma unroll
              for (int q = 0; q < 4; ++q) z += alr[j][q][0] * w[4 * q] + alr[j][q][1] * w[4 * q + 1] + alr[j][q][2] * w[4 * q + 2] + alr[j][q][3] * w[4 * q + 3];
              la[j] = (fminf(z, 0.f) - __logf(1.0f + __expf(-fabsf(z)))) * (1.0f / 16.0f); tot += la[j]; }
            float sfx = tot;
            { float t1 = __int_as_float(__builtin_amdgcn_ds_bpermute(((lane + 1) & 63) << 2, __float_as_int(sfx))); if (pc + 1 < 8) sfx += t1;
              float t2 = __int_as_float(__builtin_amdgcn_ds_bpermute(((lane + 2) & 63) << 2, __float_as_int(sfx))); if (pc + 2 < 8) sfx += t2;
              float t4 = __int_as_float(__builtin_amdgcn_ds_bpermute(((lane + 4) & 63) << 2, __float_as_int(sfx))); if (pc + 4 < 8) sfx += t4; }
            float rev = sfx - tot;
#pragma unroll
            for (int j = 7; j >= 0; --j) { kv[j] *= __expf(rev); rev += la[j]; }
            if (PROBE_PH == 4 && probe_reps == 0) *(u32x4*)((bf16_t*)(ws + SL5) + ((size_t)c * 512 + f) * 64 + 8 * pc) = pack8(kv); else *kp = pack8(kv);
            if (pc == 0) Decay[c * 512 + f] = __expf(rev);
          }
        }
      } break;
      case 5: {
        const bf16_t* KdT = (const bf16_t*)(ws + OFF_KT); const bf16_t* VT = (const bf16_t*)(ws + OFF_VT); const float* Decay = (const float*)(ws + OFF_DECAY);
        float* SL = (float*)(ws + 438 * MB);
        constexpr int A_KO = 0, A_DO = 18432, A_BF = 18944;
        const int r32 = lane & 31, hi = lane >> 5;
        for (int u = bx; u < 256; u += G) {
          const int bhu = u >> 2, seg = u & 3, b = bhu >> 2, h = bhu & 3, n0 = 8 * seg, nend = n0 + 8;
          if (seg == 3) continue;
          f32x16 S[4];
#pragma unroll
          for (int kb = 0; kb < 4; ++kb)
#pragma unroll
            for (int r = 0; r < 16; ++r) S[kb][r] = 0.f;
          u32x4 stK[2]; float sd = 0.f, dprod = 1.f; bf16x8 vcur[4], vnext[4];
          const bf16_t* vrow = VT + ((size_t)(b * 32) * 1024 + h * 256 + 32 * wave + r32) * 64 + 8 * hi;
#define GA_LOAD(n_) do { \
            _Pragma("unroll") for (int i = 0; i < 2; ++i) { const int id = tid + 512 * i; stK[i] = *(const u32x4*)(KdT + ((size_t)(b * 32 + (n_)) * 512 + h * 128 + (id >> 3)) * 64 + (id & 7) * 8); } \
            if (tid < 128) sd = Decay[(b * 32 + (n_)) * 512 + h * 128 + tid]; \
            _Pragma("unroll") for (int ts = 0; ts < 4; ++ts) vnext[ts] = *(const bf16x8*)(vrow + (size_t)(n_) * 65536 + 16 * ts); } while (0)
#define GA_STORE(buf_) do { LAS unsigned char* bs_ = lds + (buf_) * A_BF; \
            _Pragma("unroll") for (int i = 0; i < 2; ++i) { const int id = tid + 512 * i; *(LAS u32x4*)(bs_ + A_KO + (id >> 3) * 144 + (id & 7) * 16) = stK[i]; } \
            if (tid < 128) { *(LAS float*)(bs_ + A_DO + tid * 4) = sd; dprod *= sd; } } while (0)
          LDS_BARRIER();
          GA_LOAD(n0); GA_STORE(0);
#pragma unroll
          for (int ts = 0; ts < 4; ++ts) vcur[ts] = vnext[ts];
          GA_LOAD(n0 + 1);
          LDS_BARRIER();
          for (int n = n0; n < nend; ++n) {
            const LAS unsigned char* base = lds + (n & 1) * A_BF;
#pragma unroll
            for (int kb = 0; kb < 4; ++kb)
#pragma unroll
              for (int g4 = 0; g4 < 4; ++g4) { const f32x4 d4 = *(const LAS f32x4*)(base + A_DO + (32 * kb + 8 * g4 + 4 * hi) * 4);
#pragma unroll
                for (int j = 0; j < 4; ++j) S[kb][4 * g4 + j] *= d4[j]; }
#pragma unroll
            for (int ts = 0; ts < 4; ++ts)
#pragma unroll
              for (int kb = 0; kb < 4; ++kb) { const bf16x8 afr = *(const LAS bf16x8*)(base + A_KO + (32 * kb + r32) * 144 + (16 * ts + 8 * hi) * 2);
                S[kb] = __builtin_amdgcn_mfma_f32_32x32x16_bf16(afr, vcur[ts], S[kb], 0, 0, 0); }
            if (n + 1 < nend) GA_STORE((n + 1) & 1);
#pragma unroll
            for (int ts = 0; ts < 4; ++ts) vcur[ts] = vnext[ts];
            if (n + 2 < nend) GA_LOAD(n + 2);
            LDS_BARRIER();
          }
          f32x4* slp = (f32x4*)(SL + ((size_t)((bhu * 3 + seg) * 8 + wave) * 64 + lane) * 64);
#pragma unroll
          for (int kb = 0; kb < 4; ++kb)
#pragma unroll
            for (int g4 = 0; g4 < 4; ++g4) slp[kb * 4 + g4] = (f32x4){S[kb][4 * g4], S[kb][4 * g4 + 1], S[kb][4 * g4 + 2], S[kb][4 * g4 + 3]};
          if (tid < 128) ((float*)(ws + 462 * MB))[(bhu * 3 + seg) * 128 + tid] = dprod;
#undef GA_LOAD
#undef GA_STORE
        }
      } break;
      case 6: {
        const bf16_t* KdT = (const bf16_t*)(ws + OFF_KT); const bf16_t* VT = (const bf16_t*)(ws + OFF_VT); const bf16_t* Qg = (const bf16_t*)(ws + OFF_QG);
        const float* Decay = (const float*)(ws + OFF_DECAY); const bf16_t* Gs = (const bf16_t*)(ws + OFF_GS); bf16_t* Og = (bf16_t*)(ws + OFF_OG);
        constexpr int G_KOFF = 0, G_QOFF = 18432, G_DOFF = 35840, G_BUF = 36352, G_SS = 72704, G_OT = 76800;
        const int r32 = lane & 31, hi = lane >> 5;
        const float* SL = (const float*)(ws + 438 * MB);
        for (int u = bx; u < 256; u += G) {
          const int bhu = u >> 2, seg = u & 3, b = bhu >> 2, h = bhu & 3, n0 = 8 * seg, nend = n0 + 8;
          int tid_u = tid; asm volatile("" : "+v"(tid_u));
          const int tid = tid_u, lane = tid & 63, r32 = lane & 31, hi = lane >> 5;
          f32x16 S[4];
#pragma unroll
          for (int kb = 0; kb < 4; ++kb)
#pragma unroll
            for (int r = 0; r < 16; ++r) S[kb][r] = 0.f;
          for (int jp = 0; jp < seg; ++jp) {
            const f32x4* slp = (const f32x4*)(SL + ((size_t)((bhu * 3 + jp) * 8 + wave) * 64 + lane) * 64);
#pragma unroll
            for (int kb = 0; kb < 4; ++kb) {
              f32x4 d[4];
              const float* dp = (const float*)(ws + 462 * MB) + (bhu * 3 + jp) * 128 + 32 * kb + 4 * hi;
#pragma unroll
              for (int g4 = 0; g4 < 4; ++g4) d[g4] = *(const f32x4*)(dp + 8 * g4);
#pragma unroll
              for (int g4 = 0; g4 < 4; ++g4) { const f32x4 sl4 = slp[kb * 4 + g4];
#pragma unroll
                for (int j = 0; j < 4; ++j) S[kb][4 * g4 + j] = d[g4][j] * S[kb][4 * g4 + j] + sl4[j]; }
            }
          }
          u32x4 stK[2], stQ[2]; float sd = 0.f; bf16x8 vcur[4], vnext[4];
          f32x4 gnr[4];
#pragma unroll
          for (int g4 = 0; g4 < 4; ++g4) gnr[g4] = *(const f32x4*)(p.gla_gn + 32 * wave + 8 * g4 + 4 * hi);
          const bf16_t* vrow = VT + ((size_t)(b * 32) * 1024 + h * 256 + 32 * wave + r32) * 64 + 8 * hi;
#define GLA_LOAD(n_) do { const int m0_ = b * 2048 + 64 * (n_); \
            _Pragma("unroll") for (int i = 0; i < 2; ++i) { const int id = tid + 512 * i; stK[i] = *(const u32x4*)(KdT + ((size_t)(b * 32 + (n_)) * 512 + h * 128 + (id >> 3)) * 64 + (id & 7) * 8); } \
            _Pragma("unroll") for (int i = 0; i < 2; ++i) { const int id = tid + 512 * i; stQ[i] = *(const u32x4*)(Qg + (size_t)(m0_ + (id >> 4)) * 512 + h * 128 + (id & 15) * 8); } \
            if (tid < 128) sd = Decay[(b * 32 + (n_)) * 512 + h * 128 + tid]; \
            _Pragma("unroll") for (int ts = 0; ts < 4; ++ts) vnext[ts] = *(const bf16x8*)(vrow + (size_t)(n_) * 65536 + 16 * ts); } while (0)
#define GLA_STORE(buf_) do { LAS unsigned char* bs_ = lds + (buf_) * G_BUF; \
            _Pragma("unroll") for (int i = 0; i < 2; ++i) { const int id = tid + 512 * i; *(LAS u32x4*)(bs_ + G_KOFF + (id >> 3) * 144 + (id & 7) * 16) = stK[i]; } \
            _Pragma("unroll") for (int i = 0; i < 2; ++i) { const int id = tid + 512 * i; *(LAS u32x4*)(bs_ + G_QOFF + (id >> 4) * 272 + (id & 15) * 16) = stQ[i]; } \
            if (tid < 128) *(LAS float*)(bs_ + G_DOFF + tid * 4) = sd; } while (0)
          LDS_BARRIER();
          GLA_LOAD(n0); GLA_STORE(0);
#pragma unroll
          for (int ts = 0; ts < 4; ++ts) vcur[ts] = vnext[ts];
          GLA_LOAD(n0 + 1);
          LDS_BARRIER();
          for (int n = n0; n < nend; ++n) {
            const LAS unsigned char* base = lds + (n & 1) * G_BUF;
            const int m0 = b * 2048 + 64 * n;
            u32x4 gsr[4];
#pragma unroll
            for (int i = 0; i < 4; ++i) { const int id = tid + 512 * i; gsr[i] = *(const u32x4*)(Gs + (size_t)(m0 + (id >> 5)) * 1024 + h * 256 + (id & 31) * 8); }
#pragma unroll
            for (int kb = 0; kb < 4; ++kb)
#pragma unroll
              for (int g4 = 0; g4 < 4; ++g4) { const f32x4 d4 = *(const LAS f32x4*)(base + G_DOFF + (32 * kb + 8 * g4 + 4 * hi) * 4);
#pragma unroll
                for (int j = 0; j < 4; ++j) S[kb][4 * g4 + j] *= d4[j]; }
#pragma unroll
            for (int ts = 0; ts < 4; ++ts)
#pragma unroll
              for (int kb = 0; kb < 4; ++kb) { const bf16x8 afr = *(const LAS bf16x8*)(base + G_KOFF + (32 * kb + r32) * 144 + (16 * ts + 8 * hi) * 2);
                S[kb] = __builtin_amdgcn_mfma_f32_32x32x16_bf16(afr, vcur[ts], S[kb], 0, 0, 0); }
            f32x16 oT[2];
#pragma unroll
            for (int r = 0; r < 16; ++r) { oT[0][r] = 0.f; oT[1][r] = 0.f; }
#pragma unroll
            for (int kb = 0; kb < 4; ++kb)
#pragma unroll
              for (int s2 = 0; s2 < 2; ++s2) {
                u32x4 w; w.x = pk2(S[kb][8 * s2], S[kb][8 * s2 + 1]); w.y = pk2(S[kb][8 * s2 + 2], S[kb][8 * s2 + 3]); w.z = pk2(S[kb][8 * s2 + 4], S[kb][8 * s2 + 5]); w.w = pk2(S[kb][8 * s2 + 6], S[kb][8 * s2 + 7]);
                const bf16x8 sp = __builtin_bit_cast(bf16x8, w);
#pragma unroll
                for (int tb = 0; tb < 2; ++tb) { const bf16x8 qfr = *(const LAS bf16x8*)(base + G_QOFF + (32 * tb + r32) * 272 + (32 * kb + 16 * s2 + 8 * hi) * 2);
                  oT[tb] = __builtin_amdgcn_mfma_f32_32x32x16_bf16(sp, qfr, oT[tb], 0, 0, 0); }
              }
            LAS float* ssb = (LAS float*)(lds + G_SS) + (n & 1) * 512;
#pragma unroll
            for (int tb = 0; tb < 2; ++tb) { float ss = 0.f;
#pragma unroll
              for (int r = 0; r < 16; ++r) ss += oT[tb][r] * oT[tb][r];
              ss = xor_add32(ss); if (hi == 0) ssb[wave * 64 + 32 * tb + r32] = ss; }
            LDS_BARRIER();
#pragma unroll
            for (int tb = 0; tb < 2; ++tb) { float tot = 0.f;
#pragma unroll
              for (int w = 0; w < 8; ++w) tot += ssb[w * 64 + 32 * tb + r32];
              const float rinv = rsq_(tot * (1.0f / 256.0f) + EPS);
#pragma unroll
              for (int g4 = 0; g4 < 4; ++g4) { const int dv = 32 * wave + 8 * g4 + 4 * hi; const f32x4 gn4 = gnr[g4];
                u32x2 o; o.x = pk2(oT[tb][4 * g4] * rinv * gn4[0], oT[tb][4 * g4 + 1] * rinv * gn4[1]); o.y = pk2(oT[tb][4 * g4 + 2] * rinv * gn4[2], oT[tb][4 * g4 + 3] * rinv * gn4[3]);
                *(LAS u32x2*)(lds + G_OT + (32 * tb + r32) * 528 + dv * 2) = o; } }
            if (n + 1 < nend) GLA_STORE((n + 1) & 1);
#pragma unroll
            for (int ts = 0; ts < 4; ++ts) vcur[ts] = vnext[ts];
            if (n + 2 < nend) GLA_LOAD(n + 2);
            LDS_BARRIER();
#pragma unroll
            for (int i = 0; i < 4; ++i) { const int id = tid + 512 * i; const int row = id >> 5, pc = id & 31;
              float o8[8], g8[8]; unpack8(*(const LAS u32x4*)(lds + G_OT + row * 528 + pc * 16), o8); unpack8(gsr[i], g8);
#pragma unroll
              for (int j = 0; j < 8; ++j) o8[j] *= g8[j];
              *(u32x4*)(Og + (size_t)(m0 + row) * 1024 + h * 256 + pc * 8) = pack8(o8); }
          }
#undef GLA_LOAD
#undef GLA_STORE
        }
      } break;
      case 7: g = pg8::Gemm{(const bf16_t*)(ws + OFF_OG), (const bf16_t*)(ws + OFF_WGOT), MTOK, 1024, 1024}; epi = EPI_YA; break;
      case 8: g = pg8::Gemm{(const bf16_t*)(ws + OFF_CQN), (const bf16_t*)(ws + OFF_WUQT), MTOK, 1536, 256}; epi = EPI_QUP; sync = false; break;
      case 9: g = pg8::Gemm{(const bf16_t*)(ws + OFF_CKVN), (const bf16_t*)(ws + OFF_WUKT), MTOK, 1024, 128}; epi = EPI_KUP; sync = false; break;
      case 10: g = pg8::Gemm{(const bf16_t*)(ws + OFF_WUVT), (const bf16_t*)(ws + OFF_CKVN), 1024, MTOK, 128}; epi = EPI_VUPT; break;
      case 11: sync = false; break;
      case 12: {
        const bf16_t* Q = (const bf16_t*)(ws + OFF_Q); const bf16_t* Kn = (const bf16_t*)(ws + OFF_KNOPE); const bf16_t* KpeR = (const bf16_t*)(ws + OFF_KPER);
        const bf16_t* VmT = (const bf16_t*)(ws + OFF_VMT); const float* KSS = (const float*)(ws + OFF_KSS); const float* KpeSS = (const float*)(ws + OFF_KPESS); bf16_t* Om = (bf16_t*)(ws + OFF_OM);
        constexpr int A_KOFF = 0, A_VOFF = 13312, A_ROFF = 22528, A_BUF = 22784;
        const int r32 = lane & 31, hi = lane >> 5;
        const int pi = (r32 & ~12) | ((r32 & 4) << 1) | ((r32 & 8) >> 1);
        float sbound;
        { float gq = fabsf(p.qn_g[lane]), gk = fabsf(p.kn_g[lane]);
          if (lane < 32) { gq = fmaxf(gq, fabsf(p.qn_g[64 + lane])); gk = fmaxf(gk, fabsf(p.kn_g[64 + lane])); }
          gq = wave_max(gq); gk = wave_max(gk);
          sbound = fminf(9.797958971132712f * 1.4426950408889634f * gq * gk, 60.0f); }
        constexpr int A_GT = 46080;
        __syncthreads();
        if (tid < 96) *(LAS float*)(lds + A_GT + tid * 4) = p.qn_g[tid] * (tid < 64 ? p.kn_g[tid] : 1.0f);
        __syncthreads();
        for (int bh = bx; bh < 256; bh += G) {
          const int b = bh >> 4, h = bh & 15;
          for (int qb = 7; qb >= 0; --qb) {
            const int NT = 4 * qb + 4, cw = 4 * qb + (wave >> 1);
            const int qrow = b * 2048 + 256 * qb + 32 * wave + r32;
            u32x4 sk, sv, sr = {0u, 0u, 0u, 0u}; float srk = 0.f, srk2 = 0.f;
#define ATT_LOAD(t_) do { const int mk_ = b * 2048 + 64 * (t_); \
              sk = *(const u32x4*)(Kn + ((size_t)(b * 16 + h) * 2048 + 64 * (t_) + (tid >> 3)) * 64 + (tid & 7) * 8); \
              if (tid < 256) sr = *(const u32x4*)(KpeR + (size_t)(mk_ + (tid >> 2)) * 32 + (tid & 3) * 8); \
              else if (tid < 320) { srk = KSS[(mk_ + tid - 256) * 16 + h]; srk2 = KpeSS[mk_ + tid - 256]; } \
              sv = *(const u32x4*)(VmT + ((size_t)(b * 32 + (t_)) * 1024 + h * 64 + (tid >> 3)) * 64 + (tid & 7) * 8); } while (0)
#define ATT_STORE(buf_) do { LAS unsigned char* bs_ = lds + (buf_) * A_BUF; \
              *(LAS u32x4*)(bs_ + A_KOFF + (tid >> 3) * 208 + (tid & 7) * 16) = sk; \
              if (tid < 256) *(LAS u32x4*)(bs_ + A_KOFF + (tid >> 2) * 208 + 128 + (tid & 3) * 16) = sr; \
              else if (tid < 320) *(LAS float*)(bs_ + A_ROFF + (tid - 256) * 4) = rsq_((srk + srk2) * (1.0f / 96.0f) + EPS); \
              *(LAS u32x4*)(bs_ + A_VOFF + (tid >> 3) * 144 + (tid & 7) * 16) = sv; } while (0)
            ATT_LOAD(0);
            bf16x8 qf[6];
            {
              int hiq = hi; asm volatile("" : "+v"(hiq));
              u32x4 qraw[6]; float ss = 0.f;
#pragma unroll
              for (int ds = 0; ds < 6; ++ds) qraw[ds] = *(const u32x4*)(Q + (size_t)qrow * 1536 + h * 96 + 16 * ds + 8 * hiq);
              const float* cp = cosT + (size_t)qrow * 16 + 8 * hiq; const float* sp = sinT + (size_t)qrow * 16 + 8 * hiq;
              const f32x4 c0 = *(const f32x4*)cp, c1 = *(const f32x4*)(cp + 4), n0 = *(const f32x4*)sp, n1 = *(const f32x4*)(sp + 4);
#pragma unroll
              for (int ds = 0; ds < 6; ++ds) { float t8[8]; unpack8(qraw[ds], t8);
#pragma unroll
                for (int j = 0; j < 8; ++j) ss += t8[j] * t8[j]; }
              ss = xor_add32(ss);
              const float rinv = rsq_(ss * (1.0f / 96.0f) + EPS) * (0.10206207261596575f * 1.4426950408889634f);
              const LAS float* gt = (const LAS float*)(lds + A_GT) + 8 * hiq;
#pragma unroll
              for (int ds = 0; ds < 4; ++ds) {
                const f32x4 a0 = *(const LAS f32x4*)(gt + 16 * ds), a1 = *(const LAS f32x4*)(gt + 16 * ds + 4);
                float t8[8]; unpack8(qraw[ds], t8);
#pragma unroll
                for (int j = 0; j < 4; ++j) { t8[j] *= rinv * a0[j]; t8[4 + j] *= rinv * a1[j]; }
                qf[ds] = __builtin_bit_cast(bf16x8, pack8(t8));
              }
              {
                const f32x4 g10 = *(const LAS f32x4*)(gt + 64), g11 = *(const LAS f32x4*)(gt + 68), g20 = *(const LAS f32x4*)(gt + 80), g21 = *(const LAS f32x4*)(gt + 84);
                float x1[8], x2[8]; unpack8(qraw[4], x1); unpack8(qraw[5], x2);
#pragma unroll
                for (int j = 0; j < 8; ++j) { const float y1 = x1[j] * rinv * (j < 4 ? g10[j & 3] : g11[j & 3]), y2 = x2[j] * rinv * (j < 4 ? g20[j & 3] : g21[j & 3]);
                  const float c = (j < 4 ? c0[j & 3] : c1[j & 3]), sn = (j < 4 ? n0[j & 3] : n1[j & 3]);
                  x1[j] = y1 * c - y2 * sn; x2[j] = y2 * c + y1 * sn; }
                qf[4] = __builtin_bit_cast(bf16x8, pack8(x1)); qf[5] = __builtin_bit_cast(bf16x8, pack8(x2));
              }
            }
            f32x16 o0, o1;
#pragma unroll
            for (int r = 0; r < 16; ++r) { o0[r] = 0.f; o1[r] = 0.f; }
            float l = 0.f;
            ATT_STORE(0); LDS_BARRIER();
            for (int t = 0; t < NT; ++t) {
              if (t + 1 < NT) ATT_LOAD(t + 1);
              if (t <= cw) {
                const LAS unsigned char* base = lds + (t & 1) * A_BUF;
                f32x16 s0, s1;
#pragma unroll
                for (int r = 0; r < 16; ++r) { s0[r] = 0.f; s1[r] = 0.f; }
                bf16x8 ka[3], kc[3], va[4], vc[4];
#pragma unroll
                for (int hf = 0; hf < 2; ++hf) {
#pragma unroll
                  for (int d3 = 0; d3 < 3; ++d3) { const int ds = 3 * hf + d3; ka[d3] = *(const LAS bf16x8*)(base + A_KOFF + pi * 208 + ds * 32 + hi * 16); kc[d3] = *(const LAS bf16x8*)(base + A_KOFF + (32 + pi) * 208 + ds * 32 + hi * 16); }
                  __builtin_amdgcn_sched_barrier(0);
#pragma unroll
                  for (int d3 = 0; d3 < 3; ++d3) {
                    s0 = __builtin_amdgcn_mfma_f32_32x32x16_bf16(ka[d3], qf[3 * hf + d3], s0, 0, 0, 0);
                    s1 = __builtin_amdgcn_mfma_f32_32x32x16_bf16(kc[d3], qf[3 * hf + d3], s1, 0, 0, 0);
                  }
                }
#pragma unroll
                for (int s4 = 0; s4 < 4; ++s4) { va[s4] = *(const LAS bf16x8*)(base + A_VOFF + r32 * 144 + (16 * s4 + 8 * hi) * 2); vc[s4] = *(const LAS bf16x8*)(base + A_VOFF + (32 + r32) * 144 + (16 * s4 + 8 * hi) * 2); }
                const LAS f32x4* rk = (const LAS f32x4*)(base + A_ROFF);
                const f32x4 k00 = rk[2 * hi], k01 = rk[2 * hi + 1], k02 = rk[4 + 2 * hi], k03 = rk[4 + 2 * hi + 1];
                const f32x4 k10 = rk[8 + 2 * hi], k11 = rk[8 + 2 * hi + 1], k12 = rk[12 + 2 * hi], k13 = rk[12 + 2 * hi + 1];
#pragma unroll
                for (int j = 0; j < 4; ++j) {
                  s0[j] = __builtin_amdgcn_exp2f(s0[j] * k00[j] - sbound); s0[4 + j] = __builtin_amdgcn_exp2f(s0[4 + j] * k01[j] - sbound);
                  s0[8 + j] = __builtin_amdgcn_exp2f(s0[8 + j] * k02[j] - sbound); s0[12 + j] = __builtin_amdgcn_exp2f(s0[12 + j] * k03[j] - sbound);
                  s1[j] = __builtin_amdgcn_exp2f(s1[j] * k10[j] - sbound); s1[4 + j] = __builtin_amdgcn_exp2f(s1[4 + j] * k11[j] - sbound);
                  s1[8 + j] = __builtin_amdgcn_exp2f(s1[8 + j] * k12[j] - sbound); s1[12 + j] = __builtin_amdgcn_exp2f(s1[12 + j] * k13[j] - sbound); }
                float ps = 0.f;
#pragma unroll
                for (int r = 0; r < 16; ++r) ps += s0[r] + s1[r];
                l += ps;
#pragma unroll
                for (int s4 = 0; s4 < 4; ++s4) {
                  u32x4 w;
                  if (s4 == 0) { w.x = pk2(s0[0], s0[1]); w.y = pk2(s0[2], s0[3]); w.z = pk2(s0[4], s0[5]); w.w = pk2(s0[6], s0[7]); }
                  else if (s4 == 1) { w.x = pk2(s0[8], s0[9]); w.y = pk2(s0[10], s0[11]); w.z = pk2(s0[12], s0[13]); w.w = pk2(s0[14], s0[15]); }
                  else if (s4 == 2) { w.x = pk2(s1[0], s1[1]); w.y = pk2(s1[2], s1[3]); w.z = pk2(s1[4], s1[5]); w.w = pk2(s1[6], s1[7]); }
                  else { w.x = pk2(s1[8], s1[9]); w.y = pk2(s1[10], s1[11]); w.z = pk2(s1[12], s1[13]); w.w = pk2(s1[14], s1[15]); }
                  const bf16x8 pf = __builtin_bit_cast(bf16x8, w);
                  o0 = __builtin_amdgcn_mfma_f32_32x32x16_bf16(va[s4], pf, o0, 0, 0, 0);
                  o1 = __builtin_amdgcn_mfma_f32_32x32x16_bf16(vc[s4], pf, o1, 0, 0, 0);
                }
              }
              if (t + 1 < NT) ATT_STORE((t + 1) & 1);
              LDS_BARRIER();
            }
            l = xor_add32(l);
            const float li = __builtin_amdgcn_rcpf(l);
            {
              LAS unsigned char* stg = lds + 49152 + wave * 4096;
#pragma unroll
              for (int g4 = 0; g4 < 4; ++g4) {
                u32x2 w0, w1; w0.x = pk2(o0[4 * g4] * li, o0[4 * g4 + 1] * li); w0.y = pk2(o0[4 * g4 + 2] * li, o0[4 * g4 + 3] * li);
                w1.x = pk2(o1[4 * g4] * li, o1[4 * g4 + 1] * li); w1.y = pk2(o1[4 * g4 + 2] * li, o1[4 * g4 + 3] * li);
                *(LAS u32x2*)(stg + r32 * 128 + (8 * g4 + 4 * hi) * 2) = w0; *(LAS u32x2*)(stg + r32 * 128 + 64 + (8 * g4 + 4 * hi) * 2) = w1;
              }
              asm volatile("s_waitcnt lgkmcnt(0)" ::: "memory");
              bf16_t* ow = Om + (size_t)(b * 2048 + 256 * qb + 32 * wave) * 1024 + h * 64;
#pragma unroll
              for (int i = 0; i < 4; ++i) { const int row = i * 8 + (lane >> 3), ch = lane & 7;
                *(u32x4*)(ow + (size_t)row * 1024 + ch * 8) = *(const LAS u32x4*)(stg + row * 128 + ch * 16); }
              asm volatile("s_waitcnt lgkmcnt(0)" ::: "memory");
            }
          }
#undef ATT_LOAD
#undef ATT_STORE
        }
      } break;
      case 13: g = pg8::Gemm{(const bf16_t*)(ws + OFF_OM), (const bf16_t*)(ws + OFF_WMOT), MTOK, 1024, 1024}; epi = EPI_YB; break;
      case 14: g = pg8::Gemm{(const bf16_t*)(ws + OFF_MIX), (const bf16_t*)(ws + OFF_WOUTT), MTOK, 1024, 1024}; epi = EPI_WOUT; break;
      case 15: norm_mod_rows(p.out, p.norm2_g, mod, 3072, 4096, (bf16_t*)(ws + OFF_HB2), gw, NGW, lane); break;
      case 16: g = pg8::Gemm{(const bf16_t*)(ws + OFF_HB2), (const bf16_t*)(ws + OFF_W1T), MTOK, 4096, 1024}; epi = EPI_W1; break;
      case 17: g = pg8::Gemm{(const bf16_t*)(ws + OFF_HID), (const bf16_t*)(ws + OFF_W2T), MTOK, 1024, 4096}; epi = EPI_W2; sync = false; break;
    }
    if (epi >= 0) {
      __syncthreads();
      pg8::StaticOrder S; S.init(g.M, g.N, G, bx);
      EpiSwitch E{epi, ws, p.x, p.out, p.b_merge, p.q_lat_g, p.kv_lat_g, (PROBE_PH == ph && probe_reps == 0) ? 1 : 0};
      int tid2 = threadIdx.x; asm volatile("" : "+v"(tid2));
      pg8::gemm_phase(lds, g, S, E, tid2);
      __syncthreads();
    }
    if (sync) { if (G == 0x7fffffff) grid.sync(); else xcd_barrier(xbar); }
#ifdef PROBE_SYNC
    if (sync) xcd_barrier(xbar);
#endif
    if (ph == PROBE_PH && probe_reps < 1) { ++probe_reps; --ph; }
  }
}

#undef p
extern "C" void kernel_launch(void* const* d_in, const int* in_sizes, int n_in, void* d_out, int out_size, void* d_ws, size_t ws_size, hipStream_t stream) {
  static int grid_blocks = 0;
  if (!grid_blocks) {
    int dev = 0, cus = 0, per_cu = 0;
    (void)hipGetDevice(&dev);
    (void)hipDeviceGetAttribute(&cus, hipDeviceAttributeMultiprocessorCount, dev);
    (void)hipFuncSetAttribute((const void*)fwd_kernel, hipFuncAttributeMaxDynamicSharedMemorySize, (int)LDS_BYTES);
    (void)hipOccupancyMaxActiveBlocksPerMultiprocessor(&per_cu, (const void*)fwd_kernel, 512, LDS_BYTES);
    if (per_cu < 1) per_cu = 1;
    if (per_cu > 1) per_cu = 1;
    grid_blocks = cus * per_cu;
    if (ws_size < WS_END || n_in != 23) { fprintf(stderr, "kernel_launch: unexpected ws_size %zu / n_in %d\n", ws_size, n_in); }
  }
  Params p{};
  p.x = (const float*)d_in[0]; p.c = (const float*)d_in[1]; p.pos = (const int*)d_in[2];
  p.w_ada = (const float*)d_in[3]; p.b_ada = (const float*)d_in[4]; p.norm1_g = (const float*)d_in[5]; p.w_in = (const float*)d_in[6]; p.b_merge = (const float*)d_in[7];
  p.w_alpha = (const float*)d_in[8]; p.b_alpha = (const float*)d_in[9]; p.gla_gn = (const float*)d_in[10]; p.gla_w_o = (const float*)d_in[11];
  p.q_lat_g = (const float*)d_in[12]; p.w_uq = (const float*)d_in[13]; p.kv_lat_g = (const float*)d_in[14]; p.w_ukv = (const float*)d_in[15];
  p.qn_g = (const float*)d_in[16]; p.kn_g = (const float*)d_in[17]; p.mla_w_o = (const float*)d_in[18]; p.w_out = (const float*)d_in[19];
  p.norm2_g = (const float*)d_in[20]; p.w1 = (const float*)d_in[21]; p.w2 = (const float*)d_in[22];
  p.out = (float*)d_out; p.ws = (unsigned char*)d_ws;
  (void)hipMemsetAsync((unsigned char*)d_ws + OFF_CTL, 0, 16384, stream);
  void* args[] = {&p};
  hipError_t e = hipLaunchCooperativeKernel((void*)fwd_kernel, dim3(grid_blocks), dim3(512), args, LDS_BYTES, stream);
  if (e != hipSuccess) fprintf(stderr, "cooperative launch failed: %s (grid %d)\n", hipGetErrorString(e), grid_blocks);
}
```
